# Optimizing an MI355X kernel written in HIP

```python
import jax
import jax.numpy as jnp
from jax import lax
import numpy as np

D_MODEL = 1024
BATCH = 8
SEQ = 4096
DEPTH = 2

GRID_W = 64
CTX_LEN = 256
RMS_EPS = 1e-6

FN_GROUPS = 4
FN_GROUP_DIM = 64
FN_WIDTH = FN_GROUPS * FN_GROUP_DIM
NA_HEADS = 8
NA_HEAD_DIM = 64
NA_WIDTH = NA_HEADS * NA_HEAD_DIM
NA_WIN_ROWS = 8
NA_WIN_COLS = 16
HG_HEADS = 4
HG_HEAD_DIM = 64
HG_WIDTH = HG_HEADS * HG_HEAD_DIM
HG_CHUNK = 64
N_BRANCHES = 3
N_EXPERTS = 256
TOP_K = 8
EXPERT_DIM = 256
SHARED_DIM = 256
ROUTE_SCALE = 2.5
MOE_BLOCK = 128

IN_SPLITS = (FN_WIDTH, NA_WIDTH, NA_WIDTH, NA_WIDTH, HG_WIDTH, HG_WIDTH, HG_WIDTH, HG_WIDTH, HG_WIDTH, N_BRANCHES * D_MODEL)
IN_COLS = FN_WIDTH + 3 * NA_WIDTH + 5 * HG_WIDTH + N_BRANCHES * D_MODEL

kernel_name = 'hybrid_fnet_natten_hgrn2_moe_dit'


def _rms_norm(x, gain):
    xf = x.astype(jnp.float32)
    y = xf * lax.rsqrt(jnp.mean(xf * xf, axis=-1, keepdims=True) + RMS_EPS)
    return (y * gain.astype(jnp.float32)).astype(x.dtype)


def _modulate(x, gain, shift, scale):
    return _rms_norm(x, gain) * (1 + scale) + shift


def _split_cols(z):
    offs = [int(o) for o in np.cumsum(IN_SPLITS)[:-1]]
    return jnp.split(z, offs, axis=-1)


def _heads(t, n_heads):
    return t.reshape(t.shape[:-1] + (n_heads, t.shape[-1] // n_heads))


def _fourier_mix(u):
    b, n, _ = u.shape
    ug = u.reshape(b, n, FN_GROUPS, FN_GROUP_DIM).astype(jnp.float32)
    f = jnp.fft.fft2(ug, axes=(1, 3), norm='ortho')
    return jnp.real(f).reshape(b, n, FN_WIDTH).astype(u.dtype)


def _na_latent(q, k, v, k_ctx, v_ctx, rpb):
    b, n, h, dh = q.shape
    rows = n // GRID_W
    wr = min(NA_WIN_ROWS, rows)
    wc = NA_WIN_COLS
    r = jnp.arange(rows)
    key_rows = jnp.clip(r - wr // 2, 0, rows - wr)[:, None] + jnp.arange(wr)[None, :]
    col = jnp.arange(GRID_W)
    col_start = jnp.clip(col - wc // 2, 0, GRID_W - wc)
    in_win = (col[None, :] >= col_start[:, None]) & (col[None, :] < col_start[:, None] + wc)
    dr_idx = key_rows - r[:, None] + (NA_WIN_ROWS - 1)
    dc_idx = jnp.clip(col[None, :] - col[:, None], 1 - wc, wc - 1) + (wc - 1)
    bias = rpb.astype(jnp.float32)[:, dr_idx[:, :, None, None], dc_idx[None, None, :, :]]
    bias = jnp.where(in_win[None, None, None], bias, -jnp.inf)
    bias = bias.transpose(0, 1, 3, 2, 4).reshape(h, rows, GRID_W, wr * GRID_W)
    scale = dh ** -0.5
    n_loc = wr * GRID_W
    qg = q.reshape(b, rows, GRID_W, h, dh)
    kg = k.reshape(b, rows, GRID_W, h, dh)[:, key_rows].reshape(b, rows, n_loc, h, dh)
    vg = v.reshape(b, rows, GRID_W, h, dh)[:, key_rows].reshape(b, rows, n_loc, h, dh)
    s_loc = jnp.einsum('brqhd,brkhd->bhrqk', qg, kg).astype(jnp.float32) * scale + bias
    s_ctx = jnp.einsum('brqhd,bchd->bhrqc', qg, k_ctx).astype(jnp.float32) * scale
    p = jax.nn.softmax(jnp.concatenate([s_loc, s_ctx], axis=-1), axis=-1).astype(v.dtype)
    o = (jnp.einsum('bhrqk,brkhd->brqhd', p[..., :n_loc], vg)
         + jnp.einsum('bhrqc,bchd->brqhd', p[..., n_loc:], v_ctx))
    return o.reshape(b, n, h * dh)


def _ctx_attention(q, k, v):
    b, n, h, dh = q.shape
    s = jnp.einsum('bqhd,bkhd->bhqk', q, k).astype(jnp.float32) * dh ** -0.5
    p = jax.nn.softmax(s, axis=-1).astype(v.dtype)
    return jnp.einsum('bhqk,bkhd->bqhd', p, v).reshape(b, n, h * dh)


def _hgrn_gates(z, lb):
    zf = z.astype(jnp.float32)
    log_f = jnp.logaddexp(jnp.log(lb), jnp.log1p(-lb) + jax.nn.log_sigmoid(zf))
    key = (1.0 - lb) * jax.nn.sigmoid(-zf)
    return _heads(log_f, HG_HEADS), _heads(key, HG_HEADS)


def _hgrn_inputs(hq, hi, hf, hb, lb_f, lb_b):
    q = _heads(jax.nn.silu(hq.astype(jnp.float32)), HG_HEADS)
    v = _heads(hi.astype(jnp.float32), HG_HEADS)
    lf_f, k_f = _hgrn_gates(hf, lb_f)
    lf_b, k_b = _hgrn_gates(hb, lb_b)
    return q, v, lf_f, k_f, lf_b, k_b


def _hgrn_scan(q, k, v, log_f, s0):
    b, n, h, _ = q.shape
    nc = n // HG_CHUNK

    def to_chunks(t):
        return t.reshape(b, nc, HG_CHUNK, h, t.shape[-1]).transpose(1, 0, 3, 2, 4).astype(jnp.float32)

    causal = jnp.tril(jnp.ones((HG_CHUNK, HG_CHUNK), dtype=bool))[None, None, :, :, None]

    def step(s, chunk):
        qc, kc, vc, gc = chunk
        bcum = jnp.cumsum(gc, axis=2)
        o_inter = jnp.einsum('bhtk,bhkv->bhtv', qc * jnp.exp(bcum), s)
        diff = bcum[:, :, :, None, :] - bcum[:, :, None, :, :]
        decay = jnp.exp(jnp.where(causal, diff, -jnp.inf))
        a = jnp.einsum('bhtk,bhsk,bhtsk->bhts', qc, kc, decay)
        o_intra = jnp.einsum('bhts,bhsv->bhtv', a, vc)
        b_last = bcum[:, :, -1:, :]
        s_new = (jnp.exp(b_last[:, :, 0, :, None]) * s
                 + jnp.einsum('bhsk,bhsv->bhkv', kc * jnp.exp(b_last - bcum), vc))
        return s_new, o_inter + o_intra

    s_fin, o = lax.scan(step, s0, (to_chunks(q), to_chunks(k), to_chunks(v), to_chunks(log_f)))
    o = o.transpose(1, 0, 3, 2, 4).reshape(b, n, h, -1)
    return o, s_fin


def _hgrn_bidir(q, v, lf_f, k_f, lf_b, k_b, s_f0, s_b0):
    o_f, s_f = _hgrn_scan(q, k_f, v, lf_f, s_f0)
    o_b, s_b = _hgrn_scan(q[:, ::-1], k_b[:, ::-1], v[:, ::-1], lf_b[:, ::-1], s_b0)
    return o_f + o_b[:, ::-1], s_f, s_b


def _hgrn_readout(o, gate_logits, gain, dtype):
    of = o * lax.rsqrt(jnp.mean(o * o, axis=-1, keepdims=True) + RMS_EPS) * gain.astype(jnp.float32)
    y = of * jax.nn.silu(_heads(gate_logits, HG_HEADS).astype(jnp.float32))
    return y.reshape(y.shape[:2] + (HG_WIDTH,)).astype(dtype)


def _merge(y_fn, y_na, y_hg, gate_logits, w_out_l):
    d = y_fn.shape[-1]
    g = jax.nn.sigmoid(gate_logits)
    m = g[..., :d] * y_fn + g[..., d:2 * d] * y_na + g[..., 2 * d:] * y_hg
    return m @ w_out_l


def _moe(t, w_router, b_router, w_gate, w_up, w_down, ws_gate, ws_up, ws_down):
    n_tok, d = t.shape
    scores = jax.nn.sigmoid((t @ w_router).astype(jnp.float32))
    _, idx = lax.top_k(scores + b_router.astype(jnp.float32), TOP_K)
    gate = jnp.take_along_axis(scores, idx, axis=-1)
    gate = ROUTE_SCALE * gate / jnp.sum(gate, axis=-1, keepdims=True)
    n_assign = n_tok * TOP_K
    e_flat = idx.reshape(-1)
    order = jnp.argsort(e_flat)
    e_sorted = e_flat[order]
    tok_sorted = (order // TOP_K).astype(jnp.int32)
    gate_sorted = gate.reshape(-1)[order]
    counts = jnp.bincount(e_flat, length=N_EXPERTS)
    starts = jnp.cumsum(counts) - counts
    padded = (counts + MOE_BLOCK - 1) // MOE_BLOCK * MOE_BLOCK
    pad_ends = jnp.cumsum(padded)
    pad_starts = pad_ends - padded
    dest = pad_starts[e_sorted] + jnp.arange(n_assign) - starts[e_sorted]
    n_blocks = -(-n_assign // MOE_BLOCK) + N_EXPERTS
    n_slots = n_blocks * MOE_BLOCK
    slot_tok = jnp.full((n_slots,), n_tok, dtype=jnp.int32).at[dest].set(tok_sorted)
    slot_gate = jnp.zeros((n_slots,), dtype=jnp.float32).at[dest].set(gate_sorted)
    block_expert = jnp.minimum(jnp.searchsorted(pad_ends, jnp.arange(n_blocks) * MOE_BLOCK, side='right'), N_EXPERTS - 1)
    t_pad = jnp.concatenate([t, jnp.zeros((1, d), t.dtype)], axis=0)

    def expert_block(acc, blk):
        tok, g, e = blk
        xb = t_pad[tok]
        hb = jax.nn.silu(xb @ w_gate[e]) * (xb @ w_up[e])
        return acc.at[tok].add((hb @ w_down[e]) * g[:, None].astype(t.dtype)), None

    routed, _ = lax.scan(expert_block, jnp.zeros_like(t_pad),
                         (slot_tok.reshape(n_blocks, MOE_BLOCK), slot_gate.reshape(n_blocks, MOE_BLOCK), block_expert))
    shared = (jax.nn.silu(t @ ws_gate) * (t @ ws_up)) @ ws_down
    return routed[:n_tok] + shared


def setup_inputs(seed: int = 0) -> dict:
    key = jax.random.key(seed)
    ks = jax.random.split(key, 26)
    d = D_MODEL

    def nrm(k, shape, s):
        return jax.random.normal(k, shape, jnp.float32) * s

    return {
        'x': nrm(ks[0], (BATCH, SEQ, d), 1.0),
        'c': nrm(ks[1], (BATCH, d), 1.0),
        'ctx': nrm(ks[2], (BATCH, CTX_LEN, d), 1.0),
        'c_ctx': nrm(ks[3], (d,), 1.0),
        'w_ada': nrm(ks[4], (DEPTH, d, 6 * d), 0.5 * d ** -0.5),
        'b_ada': nrm(ks[5], (DEPTH, 6 * d), 0.02),
        'norm1_gain': 1.0 + nrm(ks[6], (DEPTH, d), 0.1),
        'norm2_gain': 1.0 + nrm(ks[7], (DEPTH, d), 0.1),
        'w_in': nrm(ks[8], (DEPTH, d, IN_COLS), d ** -0.5),
        'na_rpb': nrm(ks[9], (DEPTH, NA_HEADS, 2 * NA_WIN_ROWS - 1, 2 * NA_WIN_COLS - 1), 0.1),
        'hg_lower_bounds': nrm(ks[10], (DEPTH, 2, HG_WIDTH), 0.5),
        'hg_norm_gain': 1.0 + nrm(ks[11], (DEPTH, HG_HEAD_DIM), 0.1),
        'w_fn_branch': nrm(ks[12], (DEPTH, FN_WIDTH, d), FN_WIDTH ** -0.5),
        'w_na_branch': nrm(ks[13], (DEPTH, NA_WIDTH, d), NA_WIDTH ** -0.5),
        'w_hg_branch': nrm(ks[14], (DEPTH, HG_WIDTH, d), HG_WIDTH ** -0.5),
        'w_out': nrm(ks[15], (DEPTH, d, d), d ** -0.5),
        'w_router': nrm(ks[16], (DEPTH, d, N_EXPERTS), d ** -0.5),
        'b_router': nrm(ks[17], (DEPTH, N_EXPERTS), 0.01),
        'w_exp_gate': nrm(ks[18], (DEPTH, N_EXPERTS, d, EXPERT_DIM), d ** -0.5),
        'w_exp_up': nrm(ks[19], (DEPTH, N_EXPERTS, d, EXPERT_DIM), d ** -0.5),
        'w_exp_down': nrm(ks[20], (DEPTH, N_EXPERTS, EXPERT_DIM, d), EXPERT_DIM ** -0.5),
        'w_sh_gate': nrm(ks[21], (DEPTH, d, SHARED_DIM), d ** -0.5),
        'w_sh_up': nrm(ks[22], (DEPTH, d, SHARED_DIM), d ** -0.5),
        'w_sh_down': nrm(ks[23], (DEPTH, SHARED_DIM, d), SHARED_DIM ** -0.5),
        'final_gain': 1.0 + nrm(ks[24], (d,), 0.1),
    }


def reference(x, c, ctx, c_ctx, w_ada, b_ada, norm1_gain, norm2_gain, w_in, na_rpb, hg_lower_bounds,
              hg_norm_gain, w_fn_branch, w_na_branch, w_hg_branch, w_out, w_router, b_router,
              w_exp_gate, w_exp_up, w_exp_down, w_sh_gate, w_sh_up, w_sh_down, final_gain):
    b, n, d = x.shape
    nc = ctx.shape[1]
    sm = jax.nn.softmax(hg_lower_bounds.astype(jnp.float32), axis=0)
    cs = jnp.cumsum(sm, axis=0)
    lower = cs - cs[0]
    silu_c = jax.nn.silu(c)
    silu_cc = jax.nn.silu(c_ctx)
    xc = ctx
    zero_state = jnp.zeros((b, HG_HEADS, HG_HEAD_DIM, HG_HEAD_DIM), jnp.float32)
    for l in range(DEPTH):
        last = l == DEPTH - 1
        mod = (silu_c @ w_ada[l] + b_ada[l])[:, None, :]
        mod_c = (silu_cc @ w_ada[l] + b_ada[l])[None, None, :]
        sh1, sc1, g1, sh2, sc2, g2 = jnp.split(mod, 6, axis=-1)
        sh1c, sc1c, g1c, sh2c, sc2c, g2c = jnp.split(mod_c, 6, axis=-1)

        h = _modulate(x, norm1_gain[l], sh1, sc1)
        hc = _modulate(xc, norm1_gain[l], sh1c, sc1c)
        fn, q, k, v, hq, hi, hf, hb, hg, bg = _split_cols(h @ w_in[l])
        fn_c, q_c, k_c, v_c, hq_c, hi_c, hf_c, hb_c, hg_c, bg_c = _split_cols(hc @ w_in[l])
        k_ch = _heads(k_c, NA_HEADS)
        v_ch = _heads(v_c, NA_HEADS)

        o_hc, s_f, s_b = _hgrn_bidir(*_hgrn_inputs(hq_c, hi_c, hf_c, hb_c, lower[l, 0], lower[l, 1]),
                                     zero_state, zero_state)
        o_hl, _, _ = _hgrn_bidir(*_hgrn_inputs(hq, hi, hf, hb, lower[l, 0], lower[l, 1]), s_f, s_b)

        y_fn = _fourier_mix(fn) @ w_fn_branch[l]
        y_na = _na_latent(_heads(q, NA_HEADS), _heads(k, NA_HEADS), _heads(v, NA_HEADS), k_ch, v_ch, na_rpb[l]) @ w_na_branch[l]
        y_hg = _hgrn_readout(o_hl, hg, hg_norm_gain[l], x.dtype) @ w_hg_branch[l]
        x = x + g1 * _merge(y_fn, y_na, y_hg, bg, w_out[l])
        if not last:
            y_fn_c = _fourier_mix(fn_c) @ w_fn_branch[l]
            y_na_c = _ctx_attention(_heads(q_c, NA_HEADS), k_ch, v_ch) @ w_na_branch[l]
            y_hg_c = _hgrn_readout(o_hc, hg_c, hg_norm_gain[l], xc.dtype) @ w_hg_branch[l]
            xc = xc + g1c * _merge(y_fn_c, y_na_c, y_hg_c, bg_c, w_out[l])

        h2 = _modulate(x, norm2_gain[l], sh2, sc2).reshape(b * n, d)
        if last:
            tokens = h2
        else:
            h2c = _modulate(xc, norm2_gain[l], sh2c, sc2c).reshape(b * nc, d)
            tokens = jnp.concatenate([h2, h2c], axis=0)
        ffn = _moe(tokens, w_router[l], b_router[l], w_exp_gate[l], w_exp_up[l], w_exp_down[l],
                   w_sh_gate[l], w_sh_up[l], w_sh_down[l])
        x = x + g2 * ffn[:b * n].reshape(b, n, d)
        if not last:
            xc = xc + g2c * ffn[b * n:].reshape(b, nc, d)
    return _rms_norm(x, final_gain)
```

```cpp
#include <hip/hip_runtime.h>
#include <cstdio>
#include <cstdint>

namespace pg8 {
#define PG8_LAS __attribute__((address_space(3)))
typedef unsigned short bf16_t;
typedef short bf16x8 __attribute__((ext_vector_type(8)));
typedef float f32x4 __attribute__((ext_vector_type(4)));
typedef unsigned u32x4 __attribute__((ext_vector_type(4)));
typedef int v4i_t __attribute__((ext_vector_type(4)));
typedef int v8i_t __attribute__((ext_vector_type(8)));
constexpr int BM = 256, BK = 64, HALF = 128, HTB = HALF * BK * 2  , STAGE_BYTES = 8 * HTB, NXCD = 8, WGM = 8;

__host__ __device__ __forceinline__ int lds_byte(int r, int c) { const int st = (r >> 4) * 2 + (c >> 5), rr = r & 15, cc = c & 31, ob = rr * 64 + cc * 2; return st * 1024 + (ob ^ (((ob >> 9) & 1) << 5)); }
__host__ __device__ __forceinline__ void stage_rc(int b, int& R, int& C) { const int st = b / 1024, sb = b % 1024, swz = sb ^ (((sb >> 9) & 1) << 5); R = (st >> 1) * 16 + swz / 64; C = (st & 1) * 32 + (swz % 64) / 2; }
__host__ __device__ __forceinline__ int perm32(int rho) { const int n = rho >> 4, i = rho & 15; return 8 * (i >> 2) + 4 * n + (i & 3); }

constexpr int PRE_IDX_OFF = 139264, PRE_SG_OFF = PRE_IDX_OFF + 4096;
struct Unit { int pm, pn; };
struct Gemm { const bf16_t* A; const bf16_t* Bt; int lda, K; };

struct StaticOrder {
    int nM, nN, nwg, G, c;
    __host__ __device__ __forceinline__ void init(int M, int N, int G_, int c_) { nM = M / BM; nN = N / BM; nwg = nM * nN; G = G_; c = c_; }
    __host__ __device__ __forceinline__ bool next(int i, Unit& u) const {
        const int L = i * G + c; if (L >= nwg) return false;
        int wgid = L; { const int q = nwg / NXCD, r = nwg % NXCD, xcd = wgid % NXCD, off = wgid / NXCD; wgid = (xcd < r ? xcd * (q + 1) : r * (q + 1) + (xcd - r) * q) + off; }
        const int nig = WGM * nN, gid = wgid / nig, fm = gid * WGM, gsz = (nM - fm) < WGM ? (nM - fm) : WGM;
        u.pm = fm + ((wgid % nig) % gsz); u.pn = (wgid % nig) / gsz; return true;
    }
    static constexpr bool GATHER = false;
    __device__ __forceinline__ int arow(const Unit& u, int r) const { return u.pm * BM + r; }
    __device__ __forceinline__ bool routed(const Unit&) const { return false; }
    __device__ __forceinline__ const int* rowlist(const Unit&) const { return nullptr; }
};

typedef __bf16 bf16x2_t __attribute__((ext_vector_type(2)));
typedef float f32x2_t __attribute__((ext_vector_type(2)));
__device__ __forceinline__ unsigned cvt_pk_bf16(float lo, float hi) { const f32x2_t v = {lo, hi}; const bf16x2_t r = __builtin_convertvector(v, bf16x2_t); return __builtin_bit_cast(unsigned, r); }
__device__ __forceinline__ int cvt_pk_fp8_sat(float a, float b, int old, bool hi) {
    float lim; asm volatile("v_mov_b32 %0, 0x43e00000" : "=v"(lim));
    a = __builtin_amdgcn_fmed3f(a, -lim, lim); b = __builtin_amdgcn_fmed3f(b, -lim, lim);
    return hi ? __builtin_amdgcn_cvt_pk_fp8_f32(a, b, old, true) : __builtin_amdgcn_cvt_pk_fp8_f32(a, b, old, false);
}
__device__ __forceinline__ float bflo(unsigned w) { return __uint_as_float(w << 16); }
__device__ __forceinline__ float bfhi(unsigned w) { return __uint_as_float(w & 0xffff0000u); }
__device__ __forceinline__ float sigm(float x) { return 1.0f / (1.0f + __expf(-x)); }


__device__ __forceinline__ u32x4 swap_lane1(u32x4 v) { u32x4 r; r.x = (unsigned)__builtin_amdgcn_update_dpp(0, (int)v.x, 0xB1, 0xf, 0xf, false); r.y = (unsigned)__builtin_amdgcn_update_dpp(0, (int)v.y, 0xB1, 0xf, 0xf, false);
    r.z = (unsigned)__builtin_amdgcn_update_dpp(0, (int)v.z, 0xB1, 0xf, 0xf, false); r.w = (unsigned)__builtin_amdgcn_update_dpp(0, (int)v.w, 0xB1, 0xf, 0xf, false); return r; }
struct EpiBf16 {
    static constexpr bool PRE = false, PERM = true, MID = false, P16 = false, P32 = true;
    bf16_t* O; int ldc; float scale; unsigned char* G8; int gt0;
    __device__ __forceinline__ void operator()(const f32x4 (&acc)[2][2][4][2], const Unit& u, int wr, int wc, int fr, int fq) const {
        if (u.pn >= gt0) {
            const bool oq = fq & 1;
            const int row0 = u.pm * BM + wr * 64 + fr, col0 = (u.pn - gt0) * BM + wc * 64 + (oq ? 32 + 8 * (fq - 1) : 8 * fq);
            float k255 = 255.0f; asm volatile("" : "+v"(k255));
#pragma unroll
            for (int ai = 0; ai < 2; ++ai)
#pragma unroll
                for (int m = 0; m < 4; ++m) { unsigned d[2][2];
#pragma unroll
                    for (int bj = 0; bj < 2; ++bj)
#pragma unroll
                        for (int n = 0; n < 2; ++n) { unsigned w = 0;
#pragma unroll
                            for (int i = 0; i < 4; ++i) { const float sg = k255 * __builtin_amdgcn_rcpf(1.0f + __expf(-acc[ai][bj][m][n][i] * scale)); w = __builtin_amdgcn_cvt_pk_u8_f32(fmaxf(sg, 1.0f), i, w); }
                            d[bj][n] = w; }
                    const auto s0 = __builtin_amdgcn_permlane16_swap(d[0][0], d[1][0], false, false), s1 = __builtin_amdgcn_permlane16_swap(d[0][1], d[1][1], false, false);
                    u32x4 w; w.x = s0[0]; w.y = s1[0]; w.z = s0[1]; w.w = s1[1];
                    *(u32x4*)(G8 + (size_t)(row0 + ai * HALF + m * 16) * 3072 + col0) = w; }
            return; }
        const bool odd = fr & 1;
        const int row0 = u.pm * BM + wr * 64 + (fr & ~1), col0 = u.pn * BM + wc * 64 + 8 * fq + (odd ? 32 : 0);
#pragma unroll
        for (int ai = 0; ai < 2; ++ai)
#pragma unroll
            for (int m = 0; m < 4; ++m) { bf16_t* rowp = O + (size_t)(row0 + ai * HALF + m * 16) * ldc + col0;
                u32x4 w[2];
#pragma unroll
                for (int bj = 0; bj < 2; ++bj) { const f32x4 v0 = acc[ai][bj][m][0] * scale, v1 = acc[ai][bj][m][1] * scale;
                    w[bj].x = cvt_pk_bf16(v0[0], v0[1]); w[bj].y = cvt_pk_bf16(v0[2], v0[3]); w[bj].z = cvt_pk_bf16(v1[0], v1[1]); w[bj].w = cvt_pk_bf16(v1[2], v1[3]); }
                const u32x4 got = swap_lane1(odd ? w[0] : w[1]);
                *(u32x4*)rowp = odd ? got : w[0]; *(u32x4*)(rowp + ldc) = odd ? w[1] : got; }
    }
};
template <bool FIRST> struct EpiBranch {
    static constexpr bool PRE = false, PERM = true, MID = false, P16 = false, P32 = false;
    bf16_t* MG; const bf16_t* gate; int ldc, ldg; float scale;
    __device__ __forceinline__ void operator()(const f32x4 (&acc)[2][2][4][2], const Unit& u, int wr, int wc, int fr, int fq) const {
        const int row0 = u.pm * BM + wr * 64 + fr, col0 = u.pn * BM + wc * 32 + 8 * fq;
#pragma unroll
        for (int ai = 0; ai < 2; ++ai)
#pragma unroll
            for (int m = 0; m < 4; ++m) { const size_t r = (size_t)(row0 + ai * HALF + m * 16);
#pragma unroll
                for (int bj = 0; bj < 2; ++bj) { const f32x4 v0 = acc[ai][bj][m][0] * scale, v1 = acc[ai][bj][m][1] * scale;
                    const u32x4 gw = *(const u32x4*)(gate + r * ldg + col0 + bj * HALF);
                    float o[8];
                    o[0] = sigm(bflo(gw.x)) * v0[0]; o[1] = sigm(bfhi(gw.x)) * v0[1]; o[2] = sigm(bflo(gw.y)) * v0[2]; o[3] = sigm(bfhi(gw.y)) * v0[3];
                    o[4] = sigm(bflo(gw.z)) * v1[0]; o[5] = sigm(bfhi(gw.z)) * v1[1]; o[6] = sigm(bflo(gw.w)) * v1[2]; o[7] = sigm(bfhi(gw.w)) * v1[3];
                    bf16_t* dst = MG + r * ldc + col0 + bj * HALF;
                    if (!FIRST) { const u32x4 pw = *(const u32x4*)dst;
                        o[0] += bflo(pw.x); o[1] += bfhi(pw.x); o[2] += bflo(pw.y); o[3] += bfhi(pw.y); o[4] += bflo(pw.z); o[5] += bfhi(pw.z); o[6] += bflo(pw.w); o[7] += bfhi(pw.w); }
                    u32x4 w; w.x = cvt_pk_bf16(o[0], o[1]); w.y = cvt_pk_bf16(o[2], o[3]); w.z = cvt_pk_bf16(o[4], o[5]); w.w = cvt_pk_bf16(o[6], o[7]);
                    *(u32x4*)dst = w; } }
    }
};
struct EpiBranchCat {
    static constexpr bool PRE = false, PERM = true, MID = true, P16 = true, P32 = false;
    bf16_t* MG; const unsigned char* gate; int ldc, ldg; float scale;
    static __device__ __forceinline__ float ub(unsigned w, int i) { return (float)((w >> (8 * i)) & 0xffu); }
    __device__ __forceinline__ void mid(f32x4 (&acc)[2][2][4][2], const Unit& u, int seg, int wr, int wc, int fr, int fq) const {
        const int row0 = u.pm * BM + wr * 64 + fr, col0 = u.pn * BM + wc * 64 + 16 * fq;
#pragma unroll
        for (int ai = 0; ai < 2; ++ai) {
            u32x4 ga[4], gb[4];
#pragma unroll
            for (int m = 0; m < 4; ++m) { const unsigned char* gp = gate + (size_t)(row0 + ai * HALF + m * 16) * ldg + seg * 1024 + col0; ga[m] = *(const u32x4*)gp; gb[m] = *(const u32x4*)(gp + 1024); }
            __builtin_amdgcn_sched_barrier(0);
#pragma unroll
            for (int m = 0; m < 4; ++m) {
#pragma unroll
                for (int bj = 0; bj < 2; ++bj)
#pragma unroll
                    for (int n = 0; n < 2; ++n)
#pragma unroll
                        for (int i = 0; i < 4; ++i) acc[ai][bj][m][n][i] *= ub(ga[m][2 * bj + n], i) * __builtin_amdgcn_rcpf(ub(gb[m][2 * bj + n], i)); }
            __builtin_amdgcn_sched_barrier(0); }
    }
    __device__ __forceinline__ void operator()(const f32x4 (&acc)[2][2][4][2], const Unit& u, int wr, int wc, int fr, int fq) const {
        const int row0 = u.pm * BM + wr * 64 + fr, col0 = u.pn * BM + wc * 64 + 16 * fq;
        float sc = scale * (1.0f / 255.0f); asm volatile("" : "+v"(sc));
        u32x4 gws[2][4];
#pragma unroll
        for (int ai = 0; ai < 2; ++ai)
#pragma unroll
            for (int m = 0; m < 4; ++m) gws[ai][m] = *(const u32x4*)(gate + (size_t)(row0 + ai * HALF + m * 16) * ldg + 2048 + col0);
        __builtin_amdgcn_sched_barrier(0);
#pragma unroll
        for (int ai = 0; ai < 2; ++ai)
#pragma unroll
            for (int m = 0; m < 4; ++m) { const size_t r = (size_t)(row0 + ai * HALF + m * 16);
                const u32x4 gw = gws[ai][m];
                u32x4 o;
#pragma unroll
                for (int bj = 0; bj < 2; ++bj)
#pragma unroll
                    for (int n = 0; n < 2; ++n) { const f32x4 v = acc[ai][bj][m][n] * sc; const unsigned g = gw[2 * bj + n]; int w = 0;
                        w = cvt_pk_fp8_sat(ub(g, 0) * v[0], ub(g, 1) * v[1], w, false); w = cvt_pk_fp8_sat(ub(g, 2) * v[2], ub(g, 3) * v[3], w, true); o[2 * bj + n] = (unsigned)w; }
                *(u32x4*)((unsigned char*)MG + r * ldc + col0) = o; }
    }
};
template <bool SRC_F32> struct EpiResid {
    static constexpr bool PRE = false, PERM = true, MID = false, P16 = false, P32 = true;
    bf16_t* X; const float* srcl; const float* srcc; const float* gmod; int nlat; int gstride; float scale;
    __device__ __forceinline__ void operator()(const f32x4 (&acc)[2][2][4][2], const Unit& u, int wr, int wc, int fr, int fq) const {
        const int row0 = u.pm * BM + wr * 64 + fr, col0 = u.pn * BM + wc * 64 + 8 * fq;
        const int rt = u.pm * BM; const int bi = rt < nlat ? (rt >> 12) : 8;
        const float* sbase = rt < nlat ? srcl : (srcc - (size_t)nlat * 1024);
        f32x4 gv[2][2];
#pragma unroll
        for (int bj = 0; bj < 2; ++bj)
#pragma unroll
            for (int n = 0; n < 2; ++n) gv[bj][n] = *(const f32x4*)(gmod + (size_t)bi * gstride + col0 + bj * 32 + n * 4) * scale;
#pragma unroll
        for (int ai = 0; ai < 2; ++ai) {
            f32x4 sf[SRC_F32 ? 4 : 1][2][2]; u32x4 sw[SRC_F32 ? 1 : 4][2];
#pragma unroll
            for (int m = 0; m < 4; ++m) { const size_t off = (size_t)(row0 + ai * HALF + m * 16) * 1024 + col0;
#pragma unroll
                for (int bj = 0; bj < 2; ++bj) {
                    if constexpr (SRC_F32) { sf[m][bj][0] = *(const f32x4*)(sbase + off + bj * 32); sf[m][bj][1] = *(const f32x4*)(sbase + off + bj * 32 + 4); }
                    else sw[m][bj] = *(const u32x4*)(X + off + bj * 32); } }
            __builtin_amdgcn_sched_barrier(0);
#pragma unroll
            for (int m = 0; m < 4; ++m) { const size_t off = (size_t)(row0 + ai * HALF + m * 16) * 1024 + col0;
#pragma unroll
                for (int bj = 0; bj < 2; ++bj) { f32x4 s0, s1;
                    if constexpr (SRC_F32) { s0 = sf[m][bj][0]; s1 = sf[m][bj][1]; }
                    else { const u32x4 w = sw[m][bj]; s0 = (f32x4){bflo(w.x), bfhi(w.x), bflo(w.y), bfhi(w.y)}; s1 = (f32x4){bflo(w.z), bfhi(w.z), bflo(w.w), bfhi(w.w)}; }
                    const f32x4 o0 = s0 + gv[bj][0] * acc[ai][bj][m][0], o1 = s1 + gv[bj][1] * acc[ai][bj][m][1];
                    u32x4 w; w.x = cvt_pk_bf16(o0[0], o0[1]); w.y = cvt_pk_bf16(o0[2], o0[3]); w.z = cvt_pk_bf16(o1[0], o1[1]); w.w = cvt_pk_bf16(o1[2], o1[3]);
                    *(u32x4*)(X + off + bj * 32) = w; } }
            __builtin_amdgcn_sched_barrier(0); }
    }
};
struct EpiF32 {
    static constexpr bool PRE = false, PERM = false, MID = false, P16 = false, P32 = false;
    float* C; int ldc;
    __device__ __forceinline__ void operator()(const f32x4 (&acc)[2][2][4][2], const Unit& u, int wr, int wc, int fr, int fq) const {
        const int row0 = u.pm * BM + wr * 64 + fr, col0 = wc * 32 + 4 * fq;
#pragma unroll
        for (int ai = 0; ai < 2; ++ai)
#pragma unroll
            for (int m = 0; m < 4; ++m) { float* rowp = C + (size_t)(row0 + ai * HALF + m * 16) * ldc + col0;
#pragma unroll
                for (int bj = 0; bj < 2; ++bj)
#pragma unroll
                    for (int n = 0; n < 2; ++n) *(f32x4*)(rowp + bj * HALF + n * 16) = acc[ai][bj][m][n]; }
    }
};
struct EpiGateUp {
    static constexpr bool PRE = true, PERM = true, MID = false, P16 = false, P32 = false;
    bf16_t* HS; const float* SG; int nshrows; float scale; static constexpr int ncol = 2;
    __device__ __forceinline__ void pre(const Unit& u, int slot, PG8_LAS unsigned char* lds, int tid) const {
        const int w = __builtin_amdgcn_readfirstlane(tid >> 6);
        if (u.pm * BM >= nshrows && w >= 4) __builtin_amdgcn_global_load_lds((const unsigned*)(SG + u.pm * BM + (w - 4) * 64 + (tid & 63)), (PG8_LAS unsigned*)(lds + PRE_SG_OFF + slot * 1024 + (w - 4) * 256), 4, 0, 0);
    }
    __device__ __forceinline__ void operator()(const f32x4 (&acc)[2][2][4][2], const Unit& u, int wr, int wc, int fr, int fq, int slot, PG8_LAS unsigned char* lds) const {
        const int row0 = u.pm * BM + wr * 64 + fr, col0 = (u.pn % ncol) * HALF + wc * 32 + 8 * fq;
        const bool sh = u.pm * BM < nshrows;
        float sgv[2][4];
        const PG8_LAS float* sgl = (const PG8_LAS float*)(lds + PRE_SG_OFF + slot * 1024) + wr * 64 + fr;
#pragma unroll
        for (int ai = 0; ai < 2; ++ai)
#pragma unroll
            for (int m = 0; m < 4; ++m) sgv[ai][m] = sh ? 1.0f : sgl[ai * HALF + m * 16];
        const bool oq = fq & 1;
        unsigned char* base = (unsigned char*)HS + (size_t)(row0 + (oq ? 16 : 0)) * 256 + (col0 - (oq ? 8 : 0));
#pragma unroll
        for (int ai = 0; ai < 2; ++ai)
#pragma unroll
            for (int mp = 0; mp < 2; ++mp) { unsigned d[2][2];
#pragma unroll
                for (int mm = 0; mm < 2; ++mm) { const int m = 2 * mp + mm;
                    const float su = sgv[ai][m] * scale; const f32x4 g0 = acc[ai][0][m][0] * scale, g1 = acc[ai][0][m][1] * scale, u0 = acc[ai][1][m][0] * su, u1 = acc[ai][1][m][1] * su;
                    float o[8];
#pragma unroll
                    for (int j = 0; j < 4; ++j) { o[j] = g0[j] * sigm(g0[j]) * u0[j]; o[4 + j] = g1[j] * sigm(g1[j]) * u1[j]; }
                    int w0 = 0, w1 = 0; w0 = cvt_pk_fp8_sat(o[0] * 16.0f, o[1] * 16.0f, w0, false); w0 = cvt_pk_fp8_sat(o[2] * 16.0f, o[3] * 16.0f, w0, true);
                    w1 = cvt_pk_fp8_sat(o[4] * 16.0f, o[5] * 16.0f, w1, false); w1 = cvt_pk_fp8_sat(o[6] * 16.0f, o[7] * 16.0f, w1, true);
                    d[mm][0] = (unsigned)w0; d[mm][1] = (unsigned)w1; }
                const auto s0 = __builtin_amdgcn_permlane16_swap(d[0][0], d[1][0], false, false), s1 = __builtin_amdgcn_permlane16_swap(d[0][1], d[1][1], false, false);
                u32x4 w; w.x = s0[0]; w.y = s1[0]; w.z = s0[1]; w.w = s1[1];
                *(u32x4*)(base + (size_t)(ai * HALF + mp * 32) * 256) = w; }
    }
};
struct EpiDown {
    static constexpr bool PRE = false, PERM = true, MID = false, P16 = true, P32 = false;
    unsigned char* Y; static constexpr int ncol = 4;
    __device__ __forceinline__ void operator()(const f32x4 (&acc)[2][2][4][2], const Unit& u, int wr, int wc, int fr, int fq) const {
        const int row0 = u.pm * BM + wr * 64 + fr, col0 = (u.pn % ncol) * BM + wc * 64 + 16 * fq;
#pragma unroll
        for (int ai = 0; ai < 2; ++ai)
#pragma unroll
            for (int m = 0; m < 4; ++m) { const int r = row0 + ai * HALF + m * 16; u32x4 w;
#pragma unroll
                for (int q = 0; q < 4; ++q) { const f32x4 v = acc[ai][q >> 1][m][q & 1] * (1.0f / 64.0f);
                    int x = 0; x = cvt_pk_fp8_sat(v[0], v[1], x, false); x = cvt_pk_fp8_sat(v[2], v[3], x, true); w[q] = (unsigned)x; }
                *(u32x4*)(Y + (size_t)r * 1024 + col0) = w; }
    }
};

template <class Epi, class Sched, bool ALIGN_EPI = true, bool FP8 = false>
__device__ __forceinline__ void gemm_phase(PG8_LAS unsigned char* lds, const Gemm g, const Sched& S, const Epi& E, int tid_in) {
    int tid = tid_in; asm volatile("" : "+v"(tid));
    const int wid = __builtin_amdgcn_readfirstlane(tid >> 6), lane = tid & 63, wr = wid >> 2, wc = wid & 3, fr = lane & 15, fq = lane >> 4;
    int K = g.K; asm volatile("" : "+s"(K));
    const int nt = K / BK;
    constexpr bool GA = Sched::GATHER;
    unsigned voffA[2], voffB[2];
    const unsigned lda2 = (unsigned)g.lda * 2u;
#pragma unroll
    for (int i = 0; i < 2; ++i) { int R, C; stage_rc(tid * 16 + i * 8192, R, C);
        const int Rb = Epi::P16 ? ((R >> 5) * 64 + ((R & 15) >> 2) * 16 + ((R >> 4) & 1) * 4 + (R & 3)) : Epi::P32 ? ((R >> 5) * 64 + ((R & 15) >> 2) * 8 + ((R >> 4) & 1) * 4 + (R & 3)) : (Epi::PERM ? ((R & ~31) + perm32(R & 31)) : R);
        voffA[i] = (unsigned)R * lda2 + (unsigned)C * 2u; voffB[i] = (unsigned)(Rb * K + C) * 2u; }
    const size_t ahstep = (size_t)HALF * lda2, atstep = 2 * ahstep;
#define PG8_GOFF(u, h, i) ({ int R_, C_; stage_rc(tid * 16 + (i) * 8192, R_, C_); (unsigned)S.arow(u, (h) * HALF + R_) * lda2 + (unsigned)C_ * 2u; })
    const size_t kstep = (size_t)(BK * 2);
    const size_t hstep = (size_t)HALF * K * 2;
    const size_t h1step = Epi::P16 ? (size_t)16 * K : Epi::P32 ? (size_t)64 * K : hstep;
    const size_t tstep = 2 * hstep;
    const unsigned ldsw = (unsigned)wid * 1024u;
    const int aoff = lds_byte(wr * 64 + fr, fq * 8), boff = lds_byte(wc * 32 + fr, fq * 8);
#define PG8_SA(b, h) (((b) * 2 + (h)) * HTB)
#define PG8_SB(b, h) ((4 + (b) * 2 + (h)) * HTB)
#define PG8_STAGE(bufoff, gbase, voff) do { const char* gb_ = (const char*)(gbase); asm volatile("" : "+s"(gb_));   \
        _Pragma("unroll") for (int _i = 0; _i < 2; ++_i) { unsigned vo_ = (voff)[_i]; asm volatile("" : "+v"(vo_));   \
        __builtin_amdgcn_global_load_lds((const unsigned*)(gb_ + vo_), (PG8_LAS unsigned*)(lds + (bufoff) + ldsw + _i * 8192), 16, 0, 0); } } while (0)
#define PG8_STAGEB1(bufoff, gbase) PG8_STAGE(bufoff, (gbase) + h1step, voffB)
#define PG8_STAGEA(bufoff, base, o0, o1) do { const char* ab_ = (const char*)(base); asm volatile("" : "+s"(ab_)); \
        unsigned o0_ = (o0), o1_ = (o1); asm volatile("" : "+v"(o0_), "+v"(o1_)); \
        __builtin_amdgcn_global_load_lds((const unsigned*)(ab_ + o0_), (PG8_LAS unsigned*)(lds + (bufoff) + ldsw), 16, 0, 0); \
        __builtin_amdgcn_global_load_lds((const unsigned*)(ab_ + o1_), (PG8_LAS unsigned*)(lds + (bufoff) + ldsw + 8192), 16, 0, 0); } while (0)
#define PG8_SA_CUR(bufoff, h, kb) do { if constexpr (GA) { if ((h) == 0) PG8_STAGEA(bufoff, (const char*)g.A + (kb), c00, c01); else PG8_STAGEA(bufoff, (const char*)g.A + (kb), c10, c11); } \
        else PG8_STAGEA(bufoff, cA + (h) * ahstep + (kb), voffA[0], voffA[1]); } while (0)
#define PG8_CAT(x, y) __builtin_shufflevector(x, y, 0, 1, 2, 3, 4, 5, 6, 7)
#define PG8_LO(x) __builtin_bit_cast(bf16x8, __builtin_shufflevector(x, x, 0, 1, 2, 3))
#define PG8_HI(x) __builtin_bit_cast(bf16x8, __builtin_shufflevector(x, x, 4, 5, 6, 7))
#define PG8_LDA(dst, b, h) do { _Pragma("unroll") for (int m = 0; m < 4; ++m) dst[m] = PG8_CAT(*(const PG8_LAS v4i_t*)(lds + PG8_SA(b, h) + aoff + m * 2048), *(const PG8_LAS v4i_t*)(lds + PG8_SA(b, h) + aoff + m * 2048 + 1024)); } while (0)
#define PG8_LDB(dst, b, h) do { _Pragma("unroll") for (int n = 0; n < 2; ++n) dst[n] = PG8_CAT(*(const PG8_LAS v4i_t*)(lds + PG8_SB(b, h) + boff + n * 2048), *(const PG8_LAS v4i_t*)(lds + PG8_SB(b, h) + boff + n * 2048 + 1024)); } while (0)
#define PG8_MMA(ai, bj, At, Bt) do { __builtin_amdgcn_s_setprio(1); _Pragma("unroll") for (int m = 0; m < 4; ++m) _Pragma("unroll") for (int n = 0; n < 2; ++n) { \
        if constexpr (FP8) acc[ai][bj][m][n] = __builtin_amdgcn_mfma_scale_f32_16x16x128_f8f6f4(Bt[n], At[m], acc[ai][bj][m][n], 0, 0, 0, 0, 0, 0); \
        else { acc[ai][bj][m][n] = __builtin_amdgcn_mfma_f32_16x16x32_bf16(PG8_LO(Bt[n]), PG8_LO(At[m]), acc[ai][bj][m][n], 0, 0, 0); \
               acc[ai][bj][m][n] = __builtin_amdgcn_mfma_f32_16x16x32_bf16(PG8_HI(Bt[n]), PG8_HI(At[m]), acc[ai][bj][m][n], 0, 0, 0); } } __builtin_amdgcn_s_setprio(0); } while (0)
#define PG8_LDA2(dst, b, h, mb) do { _Pragma("unroll") for (int m = 0; m < 2; ++m) dst[m] = PG8_CAT(*(const PG8_LAS v4i_t*)(lds + PG8_SA(b, h) + aoff + ((mb) + m) * 2048), *(const PG8_LAS v4i_t*)(lds + PG8_SA(b, h) + aoff + ((mb) + m) * 2048 + 1024)); } while (0)
#define PG8_MMA2(ai, bj, At, Bt, mb) do { _Pragma("unroll") for (int m = 0; m < 2; ++m) _Pragma("unroll") for (int n = 0; n < 2; ++n) \
        acc[ai][bj][(mb) + m][n] = __builtin_amdgcn_mfma_scale_f32_16x16x128_f8f6f4(Bt[n], At[m], acc[ai][bj][(mb) + m][n], 0, 0, 0, 0, 0, 0); } while (0)
#define PG8_LDA1(dst, b, h, mi) do { dst = PG8_CAT(*(const PG8_LAS v4i_t*)(lds + PG8_SA(b, h) + aoff + (mi) * 2048), *(const PG8_LAS v4i_t*)(lds + PG8_SA(b, h) + aoff + (mi) * 2048 + 1024)); } while (0)
#define PG8_MMA1(ai, Af, mi) do { _Pragma("unroll") for (int n = 0; n < 2; ++n) { \
        acc[ai][0][mi][n] = __builtin_amdgcn_mfma_scale_f32_16x16x128_f8f6f4(B0[n], Af, acc[ai][0][mi][n], 0, 0, 0, 0, 0, 0); \
        acc[ai][1][mi][n] = __builtin_amdgcn_mfma_scale_f32_16x16x128_f8f6f4(B1[n], Af, acc[ai][1][mi][n], 0, 0, 0, 0, 0, 0); } } while (0)
#define PG8_SP8(ai, b, h, LOADS) do { LOADS; PG8_LDA1(At[2], b, h, 2); PG8_LDA1(At[3], b, h, 3); PG8_WAIT_V(8); __builtin_amdgcn_s_waitcnt(0xC07F)  ; PG8_BAR; __builtin_amdgcn_s_setprio(1); PG8_MMA1(ai, At[0], 0); PG8_MMA1(ai, At[1], 1); PG8_MMA1(ai, At[2], 2); PG8_MMA1(ai, At[3], 3); __builtin_amdgcn_s_setprio(0); PG8_BAR; PG8_SCHED; } while (0)
#define PG8_WAIT_V(n) asm volatile("s_waitcnt vmcnt(" #n ")" ::: "memory")
#define PG8_WAIT_L(n) asm volatile("s_waitcnt lgkmcnt(" #n ")" ::: "memory")
#define PG8_BAR __builtin_amdgcn_s_barrier()
#define PG8_SCHED __builtin_amdgcn_sched_barrier(0)
    Unit cur, nxt; int ui = 0;
    if (!S.next(0, cur)) return;
    f32x4 acc[2][2][4][2];
#pragma unroll
    for (int a = 0; a < 2; ++a)
#pragma unroll
        for (int b = 0; b < 2; ++b)
#pragma unroll
            for (int m = 0; m < 4; ++m)
#pragma unroll
                for (int n = 0; n < 2; ++n) acc[a][b][m][n] = (f32x4){0.f, 0.f, 0.f, 0.f};
    v8i_t At[4], B0[2], B1[2];
    unsigned c00 = 0, c01 = 0, c10 = 0, c11 = 0;
    if constexpr (GA) { c00 = PG8_GOFF(cur, 0, 0); c01 = PG8_GOFF(cur, 0, 1); c10 = PG8_GOFF(cur, 1, 0); c11 = PG8_GOFF(cur, 1, 1); }
    if constexpr (Epi::PRE) E.pre(cur, 0, lds, tid);
#define PG8_GOFF_L(u, slot, h, i) ({ int R_, C_; stage_rc(tid * 16 + (i) * 8192, R_, C_); const int r_ = S.routed(u) ? ((const PG8_LAS int*)(lds + PRE_IDX_OFF + (slot) * 1024))[(h) * HALF + R_] : u.pm * BM + (h) * HALF + R_; (unsigned)r_ * lda2 + (unsigned)C_ * 2u; })
    const char* cA = (const char*)g.A + (size_t)cur.pm * atstep;
    const char* cB = (const char*)g.Bt + (size_t)cur.pn * tstep;
    PG8_STAGE(PG8_SB(0, 0), cB, voffB); PG8_STAGEB1(PG8_SB(0, 1), cB); PG8_SA_CUR(PG8_SA(0, 0), 0, 0); PG8_SA_CUR(PG8_SA(0, 1), 1, 0);
    if (wr == 1) PG8_BAR;
    PG8_WAIT_V(2); PG8_BAR;
    PG8_STAGE(PG8_SB(1, 0), cB + kstep, voffB); PG8_SA_CUR(PG8_SA(1, 0), 0, kstep); PG8_STAGEB1(PG8_SB(1, 1), cB + kstep);
    PG8_WAIT_V(6); PG8_BAR;
    for (;;) {
        const bool has_next = S.next(ui + 1, nxt);
        const char* nB = has_next ? (const char*)g.Bt + (size_t)nxt.pn * tstep : cB;
        const char* nA = has_next ? (const char*)g.A + (size_t)nxt.pm * atstep : cA;
        if constexpr (GA) { if (has_next && S.routed(nxt) && wid < 4) __builtin_amdgcn_global_load_lds((const unsigned*)(S.rowlist(nxt) + wid * 64 + lane), (PG8_LAS unsigned*)(lds + PRE_IDX_OFF + ((ui + 1) & 3) * 1024 + wid * 256), 4, 0, 0); }
        if constexpr (Epi::PRE) { if (has_next) E.pre(nxt, (ui + 1) & 3, lds, tid); }
        for (int t = 0; t < nt; t += 2) {
            const bool last = (t == nt - 2);
            const size_t kb1 = (size_t)(t + 1) * kstep;
            const size_t kb2 = last ? (size_t)0 : (size_t)(t + 2) * kstep;
            const char* b2 = last ? nB : cB + (size_t)(t + 2) * kstep;
            size_t kb3 = kb2 + kstep; const char* b3 = b2 + kstep;
            asm volatile("" : "+s"(kb3), "+s"(b3));
            if constexpr (FP8) {
            PG8_SP8(0, 0, 0, PG8_LDB(B0, 0, 0); PG8_LDB(B1, 0, 1); PG8_SCHED; PG8_LDA2(At, 0, 0, 0); PG8_SA_CUR(PG8_SA(1, 1), 1, kb1));
            if (last) { cA = nA; if constexpr (GA) { if (has_next) { const int sl_ = (ui + 1) & 3; c00 = PG8_GOFF_L(nxt, sl_, 0, 0); c01 = PG8_GOFF_L(nxt, sl_, 0, 1); c10 = PG8_GOFF_L(nxt, sl_, 1, 0); c11 = PG8_GOFF_L(nxt, sl_, 1, 1); } } }
            PG8_SP8(1, 0, 1, PG8_LDA2(At, 0, 1, 0); PG8_STAGE(PG8_SB(0, 0), b2, voffB); PG8_STAGEB1(PG8_SB(0, 1), b2); PG8_SA_CUR(PG8_SA(0, 0), 0, kb2));
            PG8_SP8(0, 1, 0, PG8_LDB(B0, 1, 0); PG8_LDB(B1, 1, 1); PG8_SCHED; PG8_LDA2(At, 1, 0, 0); PG8_SA_CUR(PG8_SA(0, 1), 1, kb2));
            PG8_SP8(1, 1, 1, PG8_LDA2(At, 1, 1, 0); PG8_STAGE(PG8_SB(1, 0), b3, voffB); PG8_STAGEB1(PG8_SB(1, 1), b3); PG8_SA_CUR(PG8_SA(1, 0), 0, kb3));
            if constexpr (Epi::MID) { if (t == 0 || t == 4) { int fr_ = fr, fq_ = fq; asm volatile("" : "+v"(fr_), "+v"(fq_)); E.mid(acc, cur, t == 0 ? 0 : 1, wr, wc, fr_, fq_); } }
            } else {
            PG8_LDB(B0, 0, 0); PG8_LDB(B1, 0, 1); PG8_SCHED; PG8_LDA(At, 0, 0); PG8_SA_CUR(PG8_SA(1, 1), 1, kb1);
            PG8_WAIT_V(8); PG8_WAIT_L(0); PG8_BAR; PG8_MMA(0, 0, At, B0); PG8_MMA(0, 1, At, B1); PG8_BAR; PG8_SCHED;
            if (last) { cA = nA; if constexpr (GA) { if (has_next) { const int sl_ = (ui + 1) & 3; c00 = PG8_GOFF_L(nxt, sl_, 0, 0); c01 = PG8_GOFF_L(nxt, sl_, 0, 1); c10 = PG8_GOFF_L(nxt, sl_, 1, 0); c11 = PG8_GOFF_L(nxt, sl_, 1, 1); } } }
            PG8_LDA(At, 0, 1); PG8_STAGE(PG8_SB(0, 0), b2, voffB); PG8_STAGEB1(PG8_SB(0, 1), b2); PG8_SA_CUR(PG8_SA(0, 0), 0, kb2);
            PG8_WAIT_V(8); PG8_WAIT_L(0); PG8_BAR; PG8_MMA(1, 0, At, B0); PG8_MMA(1, 1, At, B1); PG8_BAR; PG8_SCHED;
            PG8_LDB(B0, 1, 0); PG8_LDB(B1, 1, 1); PG8_SCHED; PG8_LDA(At, 1, 0); PG8_SA_CUR(PG8_SA(0, 1), 1, kb2);
            PG8_WAIT_V(8); PG8_WAIT_L(0); PG8_BAR; PG8_MMA(0, 0, At, B0); PG8_MMA(0, 1, At, B1); PG8_BAR; PG8_SCHED;
            PG8_LDA(At, 1, 1); PG8_STAGE(PG8_SB(1, 0), b3, voffB); PG8_STAGEB1(PG8_SB(1, 1), b3); PG8_SA_CUR(PG8_SA(1, 0), 0, kb3);
            PG8_WAIT_V(8); PG8_WAIT_L(0); PG8_BAR; PG8_MMA(1, 0, At, B0); PG8_MMA(1, 1, At, B1); PG8_BAR; PG8_SCHED;
        }
            }
        if constexpr (ALIGN_EPI) { if (wr == 0) PG8_BAR; }
        { int fr_ = fr, fq_ = fq; asm volatile("" : "+v"(fr_), "+v"(fq_)); if constexpr (Epi::PRE) E(acc, cur, wr, wc, fr_, fq_, ui & 3, lds); else E(acc, cur, wr, wc, fr_, fq_); }
        if (!has_next) break;
#pragma unroll
        for (int a = 0; a < 2; ++a)
#pragma unroll
            for (int b = 0; b < 2; ++b)
#pragma unroll
                for (int m = 0; m < 4; ++m)
#pragma unroll
                    for (int n = 0; n < 2; ++n) acc[a][b][m][n] = (f32x4){0.f, 0.f, 0.f, 0.f};
        cur = nxt; cB = nB; ++ui;
        if constexpr (ALIGN_EPI) { if (wr == 1) PG8_BAR; }
    }
    PG8_WAIT_V(0);
    if constexpr (!ALIGN_EPI) { if (wr == 0) PG8_BAR; }
    PG8_BAR;
#undef PG8_SA
#undef PG8_SB
#undef PG8_STAGE
#undef PG8_STAGEA
#undef PG8_STAGEB1
#undef PG8_SA_CUR
#undef PG8_GOFF
#undef PG8_GOFF_L
#undef PG8_LDA
#undef PG8_LDB
#undef PG8_MMA
#undef PG8_LDA2
#undef PG8_LDA1
#undef PG8_MMA1
#undef PG8_MMA2
#undef PG8_SP8
#undef PG8_CAT
#undef PG8_LO
#undef PG8_HI
#undef PG8_WAIT_V
#undef PG8_WAIT_L
#undef PG8_BAR
#undef PG8_SCHED
}
}

constexpr int NWAVES = 8;
constexpr int D = 1024, BATCH = 8, SEQ = 4096, NLAT = BATCH * SEQ, CTXL = 256, NCTX = BATCH * CTXL, T = NLAT + NCTX;
constexpr int DEPTH = 2, INC = 6144, NE = 256, TOPK = 8;
constexpr int C_FN = 0, C_Q = 256, C_K = 768, C_V = 1280, C_HQ = 1792, C_HI = 2048, C_HF = 2304, C_HB = 2560, C_HG = 2816, C_BG = 3072;
constexpr int M_SH1 = 0, M_SC1 = 1024, M_G1 = 2048, M_SH2 = 3072, M_SC2 = 4096, M_G2 = 5120;
constexpr int NSHT = T / 256;
constexpr int MAXRT = (NLAT + NCTX) * TOPK / 256 + NE;
constexpr int NCHUNK = 68;
constexpr float RMS_EPS = 1e-6f;
constexpr float LOG2E = 1.4426950408889634f;

constexpr size_t MiB = 1u << 20;
constexpr size_t WS_CTL = 0, CTL_ZERO_BYTES = 2 * MiB;
constexpr size_t WS_MOD = 2 * MiB;
constexpr size_t WS_CS64 = 2 * MiB + 512 * 1024;
constexpr size_t WS_TW = 2 * MiB + 576 * 1024;
constexpr size_t WS_CS256 = 3 * MiB;
constexpr size_t WS_W = 4 * MiB, W_LSTRIDE = 404 * MiB;
constexpr size_t W_IN = 0, W_FN = 12 * MiB, W_NA = 12 * MiB + 512 * 1024, W_HG = 13 * MiB + 512 * 1024, W_OUT = 14 * MiB, W_R = 16 * MiB, W_GU = 17 * MiB, W_D = 274 * MiB;
constexpr size_t WS_H = 812 * MiB;
constexpr size_t WS_X = 880 * MiB;
constexpr size_t WS_HS = 1016 * MiB;
constexpr size_t WS_SC = 1201 * MiB;
constexpr size_t WS_TKE = 1235 * MiB, WS_TKP = WS_TKE + 1088 * 1024, WS_TKG = WS_TKP + 1088 * 1024, WS_TSL = WS_TKG + 1088 * 1024;
constexpr size_t WS_STOK = 1240 * MiB;
constexpr size_t WS_SG = 1241 * MiB + 512 * 1024;
constexpr size_t WS_Y = 1243 * MiB;
constexpr size_t WS_Z = WS_Y, WS_MIX = WS_Y + 408 * MiB, WS_MG = WS_Y + 476 * MiB, WS_HL = WS_Y + 544 * MiB, WS_HSP = WS_Y + 612 * MiB, WS_HDEC = WS_Y + 646 * MiB,
                 WS_VTL = WS_Y + 648 * MiB, WS_VTC = WS_Y + 680 * MiB, WS_T1R = WS_Y + 682 * MiB, WS_T1I = WS_Y + 698 * MiB, WS_CP = WS_Y + 714 * MiB;
constexpr size_t WS_G8 = WS_HS;
constexpr size_t WS_H8 = 1983 * MiB;
constexpr size_t WS_END = 2017 * MiB;
constexpr float W8_SCALE = 64.0f;
static_assert(WS_CP + 4 * MiB <= WS_Y + 740 * MiB && WS_Y + 740 * MiB <= WS_END, "ws map");
constexpr int CW_TMO = 0, CW_TRQ = 64, CW_BAR = 4096, CW_CNT = 16384;

constexpr int RING_BYTES = 131072;
constexpr int LDSCTL_OFF = RING_BYTES, MISC_OFF = LDSCTL_OFF + 320, TE_OFF = MISC_OFF + 192, LDS_BYTES = 147456;
static_assert(TE_OFF + 2 * (MAXRT + 8) + 16 <= LDS_BYTES, "LDS map");

#define GAS __attribute__((address_space(1)))
#define LAS __attribute__((address_space(3)))
#define DI __device__ __forceinline__
typedef unsigned short bf16;
typedef unsigned v4u __attribute__((ext_vector_type(4)));
typedef unsigned v2u __attribute__((ext_vector_type(2)));
typedef float f32x4 __attribute__((ext_vector_type(4)));
typedef short bf16x8 __attribute__((ext_vector_type(8)));
typedef GAS unsigned gu32;
#define RLX_AGENT __ATOMIC_RELAXED, __HIP_MEMORY_SCOPE_AGENT
#define VM_WAIT() asm volatile("s_waitcnt vmcnt(0)" ::: "memory")
DI float bf2f(unsigned v) { return __uint_as_float(v << 16); }
DI float bflo(unsigned w) { return __uint_as_float(w << 16); }
DI float bfhi(unsigned w) { return __uint_as_float(w & 0xffff0000u); }
DI unsigned pk2(float lo, float hi) { return pg8::cvt_pk_bf16(lo, hi); }
DI unsigned f2bf(float f) { return pk2(f, 0.f) & 0xffffu; }
DI unsigned pk4_fp8w(float a, float b, float c, float d) { int w = 0; w = __builtin_amdgcn_cvt_pk_fp8_f32(a, b, w, false); w = __builtin_amdgcn_cvt_pk_fp8_f32(c, d, w, true); return (unsigned)w; }
DI unsigned pk4_fp8(float a, float b, float c, float d) { int w = 0; w = pg8::cvt_pk_fp8_sat(a, b, w, false); w = pg8::cvt_pk_fp8_sat(c, d, w, true); return (unsigned)w; }
DI float sigm(float x) { return 1.0f / (1.0f + __expf(-x)); }
DI float shx(float v, int o, int lane) { return __builtin_bit_cast(float, __builtin_amdgcn_ds_bpermute((lane ^ o) << 2, __builtin_bit_cast(int, v))); }
DI float wave_sum(float v, int lane) {
#pragma unroll
    for (int o = 1; o < 64; o <<= 1) v += shx(v, o, lane);
    return v;
}
DI f32x4 mfma16(bf16x8 a, bf16x8 b, f32x4 c) { return __builtin_amdgcn_mfma_f32_16x16x32_bf16(a, b, c, 0, 0, 0); }
DI bf16x8 ldfrag(const LAS bf16* img, int pitch, int r0, int k0, int lane) { return *(const LAS bf16x8*)(img + (r0 + (lane & 15)) * pitch + k0 + 8 * (lane >> 4)); }

#define XB_TMO      128
#define XB_XCNT(j)  (256  + 64 * (j))
#define XB_XSUB(j)  (1280 + 64 * (j))
#define XB_XGEN(j)  (2304 + 64 * (j))
#define XB_TOP      3328
#define XB_TOPGEN   3392
#define XCD_BAR_WORDS 3456
#define XB_SPIN_CAP (1u << 18)

__device__ __forceinline__ unsigned xb_ld(unsigned* p)              { return __hip_atomic_load(p, __ATOMIC_RELAXED, __HIP_MEMORY_SCOPE_AGENT); }
__device__ __forceinline__ unsigned xb_add(unsigned* p, unsigned v) { return __hip_atomic_fetch_add(p, v, __ATOMIC_RELAXED, __HIP_MEMORY_SCOPE_AGENT); }
__device__ __forceinline__ unsigned xb_xcc_id() { return (unsigned)__builtin_amdgcn_s_getreg((3 << 11) | 20) & 0xFu; }
#define XB_SPIN(cond, bar) do { unsigned _sp = 0; while (cond) { __builtin_amdgcn_s_sleep(1); \
    if ((++_sp & 255u) == 0u) { if (xb_ld(&(bar)[XB_TMO])) break; if (_sp > XB_SPIN_CAP) { atomicAdd(&(bar)[XB_TMO], 1u); break; } } } } while (0)

struct XcdBarrier {
    unsigned* bar; unsigned x;
    volatile LAS unsigned* st;
};

__device__ __forceinline__ XcdBarrier xcd_barrier_post(unsigned* bar, volatile LAS unsigned* st, bool t0) {
    XcdBarrier b; b.bar = bar; b.x = xb_xcc_id(); b.st = st;
    if (t0) (void)xb_add(&bar[XB_XCNT(b.x)], 1u);
    return b;
}
__device__ __forceinline__ void xcd_barrier_complete(unsigned* bar, unsigned x, unsigned& nloc, unsigned& nx) {
    const unsigned G = gridDim.x * gridDim.y * gridDim.z;
    unsigned sum, cnt, mine, sp = 0u;
    for (;;) {
        sum = 0u; cnt = 0u; mine = 0u;
#pragma unroll
        for (unsigned j = 0; j < 16; ++j) { const unsigned c = xb_ld(&bar[XB_XCNT(j)]); sum += c; cnt += (c > 0u) ? 1u : 0u; mine = (j == x) ? c : mine; }
        if (sum == G) break;
        __builtin_amdgcn_s_sleep(1);
        if ((++sp & 255u) == 0u) { if (xb_ld(&bar[XB_TMO])) break; if (sp > XB_SPIN_CAP) { atomicAdd(&bar[XB_TMO], 1u); break; } }
    }
    nloc = mine > 0u ? mine : 1u; nx = cnt > 0u ? cnt : 1u;
}

__device__ __forceinline__ void xcd_barrier(const XcdBarrier& b, bool t0) {
    asm volatile("s_waitcnt vmcnt(0)" ::: "memory");
    __syncthreads();
    if (t0) {
        unsigned* bar = b.bar;
        __builtin_amdgcn_s_waitcnt(0);
        unsigned nloc = b.st[0], nx = b.st[1];
        if (nloc == 0u) { xcd_barrier_complete(bar, b.x, nloc, nx); b.st[0] = nloc; b.st[1] = nx; }
        const unsigned old = xb_add(&bar[XB_XSUB(b.x)], 1u);
        const unsigned gen = old / nloc;
        if (old + 1u == (gen + 1u) * nloc) {
            __builtin_amdgcn_fence(__ATOMIC_RELEASE, "agent");
            asm volatile("s_waitcnt vmcnt(0)" ::: "memory");
            const unsigned og = xb_add(&bar[XB_TOP], 1u);
            const unsigned tg = og / nx;
            if (og + 1u == (tg + 1u) * nx) xb_add(&bar[XB_TOPGEN], 1u);
            else XB_SPIN(xb_ld(&bar[XB_TOPGEN]) == tg, bar);
            __builtin_amdgcn_fence(__ATOMIC_ACQUIRE, "agent");
            xb_add(&bar[XB_XGEN(b.x)], 1u);
            asm volatile("s_waitcnt vmcnt(0)" ::: "memory");
        } else {
            XB_SPIN(xb_ld(&bar[XB_XGEN(b.x)]) == gen, bar);
            __builtin_amdgcn_fence(__ATOMIC_ACQUIRE, "agent");
            asm volatile("s_waitcnt vmcnt(0)" ::: "memory");
        }
    }
    __syncthreads();
}


struct Args { const float* in[25]; float* out; unsigned char* ws; int ph_lo, ph_hi; };
struct Ctx {
    const float* in[25]; size_t z; float* out; unsigned char* ws; LAS unsigned char* lds;
    int tid, lane, wave, bid, G;
};
enum { I_X = 0, I_C, I_CTX, I_CCTX, I_WADA, I_BADA, I_N1G, I_N2G, I_WIN, I_RPB, I_HGLB, I_HGNG, I_WFN, I_WNA, I_WHG, I_WOUT, I_WR, I_BR, I_WEG, I_WEU, I_WED, I_WSG, I_WSU, I_WSD, I_FG };
DI const float* inp(const Ctx& C, int k) { return C.in[k] + C.z; }
DI bf16* wsb(const Ctx& C, size_t off) { return (bf16*)(C.ws + off); }
DI float* wsf(const Ctx& C, size_t off) { return (float*)(C.ws + off); }
DI int* wsi(const Ctx& C, size_t off) { return (int*)(C.ws + off); }
DI bf16* wl(const Ctx& C, int l, size_t off) { return (bf16*)(C.ws + WS_W + (size_t)l * W_LSTRIDE + off); }
DI const float* modp(const Ctx& C, int l, int bi, int off) { return (const float*)(C.ws + WS_MOD) + ((size_t)(l * 9 + bi)) * 6144 + off; }

DI void tr_item(const float* W, int N, int k0, int n0, bf16* WT, size_t drow0, int Kd, int lane) {
    float v[32];
#pragma unroll
    for (int i = 0; i < 32; ++i) v[i] = W[(size_t)(k0 + i) * N + n0 + lane];
    bf16* o = WT + (drow0 + lane) * (size_t)Kd + k0;
#pragma unroll
    for (int c = 0; c < 4; ++c) { v4u w; w.x = pk2(v[8 * c], v[8 * c + 1]); w.y = pk2(v[8 * c + 2], v[8 * c + 3]); w.z = pk2(v[8 * c + 4], v[8 * c + 5]); w.w = pk2(v[8 * c + 6], v[8 * c + 7]);
        *(v4u*)(o + 8 * c) = w; }
}
DI void tr_item8(const float* W, int N, int k0, int n0, unsigned char* WT8, size_t drow0, int Kd, int lane) {
    float v[32];
#pragma unroll
    for (int i = 0; i < 32; ++i) v[i] = W[(size_t)(k0 + i) * N + n0 + lane] * W8_SCALE;
    unsigned char* o = WT8 + (drow0 + lane) * (size_t)Kd + k0;
#pragma unroll
    for (int c = 0; c < 2; ++c) { v4u w; w.x = pk4_fp8(v[16 * c], v[16 * c + 1], v[16 * c + 2], v[16 * c + 3]); w.y = pk4_fp8(v[16 * c + 4], v[16 * c + 5], v[16 * c + 6], v[16 * c + 7]);
        w.z = pk4_fp8(v[16 * c + 8], v[16 * c + 9], v[16 * c + 10], v[16 * c + 11]); w.w = pk4_fp8(v[16 * c + 12], v[16 * c + 13], v[16 * c + 14], v[16 * c + 15]); *(v4u*)(o + 16 * c) = w; }
}
constexpr int TR_PER_LAYER = 2112 + 49344;
struct TrItem { const float* src; unsigned char* dst; int N; bool f8; };
DI TrItem tr_decode(const Ctx& C, int it) {
    const int l = it / TR_PER_LAYER; int r = it - l * TR_PER_LAYER;
    const float* W; int N, kb, nb, Kd, koff = 0; size_t woff, drow0; bool f8 = false;
    if (r < 1536) { f8 = true; W = inp(C, I_WIN) + (size_t)l * 1024 * 6144; N = 6144; nb = r >> 4; kb = r & 15; woff = W_IN; drow0 = (size_t)nb * 64; Kd = 1024; }
    else if ((r -= 1536) < 64) { f8 = true; W = inp(C, I_WFN) + (size_t)l * 256 * 1024; N = 1024; nb = r >> 2; kb = r & 3; woff = W_FN; drow0 = (size_t)nb * 64; Kd = 1024; koff = 0; }
    else if ((r -= 64) < 128) { f8 = true; W = inp(C, I_WNA) + (size_t)l * 512 * 1024; N = 1024; nb = r >> 3; kb = r & 7; woff = W_FN; drow0 = (size_t)nb * 64; Kd = 1024; koff = 256; }
    else if ((r -= 128) < 64) { f8 = true; W = inp(C, I_WHG) + (size_t)l * 256 * 1024; N = 1024; nb = r >> 2; kb = r & 3; woff = W_FN; drow0 = (size_t)nb * 64; Kd = 1024; koff = 768; }
    else if ((r -= 64) < 256) { f8 = true; W = inp(C, I_WOUT) + (size_t)l * 1024 * 1024; N = 1024; nb = r >> 4; kb = r & 15; woff = W_OUT; drow0 = (size_t)nb * 64; Kd = 1024; }
    else if ((r -= 256) < 64) { W = inp(C, I_WR) + (size_t)l * 1024 * 256; N = 256; nb = r >> 4; kb = r & 15; woff = W_R; drow0 = (size_t)nb * 64; Kd = 1024; }
    else if ((r -= 64) < 16384) { f8 = true; const int e = r >> 6, q2 = r & 63; W = inp(C, I_WEG) + ((size_t)(l * 256 + e)) * 1024 * 256; N = 256; nb = q2 >> 4; kb = q2 & 15; woff = W_GU; drow0 = (size_t)e * 512 + (nb >> 1) * 256 + (nb & 1) * 64; Kd = 1024; }
    else if ((r -= 16384) < 16384) { f8 = true; const int e = r >> 6, q2 = r & 63; W = inp(C, I_WEU) + ((size_t)(l * 256 + e)) * 1024 * 256; N = 256; nb = q2 >> 4; kb = q2 & 15; woff = W_GU; drow0 = (size_t)e * 512 + (nb >> 1) * 256 + 128 + (nb & 1) * 64; Kd = 1024; }
    else if ((r -= 16384) < 16384) { f8 = true; const int e = r >> 6, q2 = r & 63; W = inp(C, I_WED) + ((size_t)(l * 256 + e)) * 256 * 1024; N = 1024; nb = q2 >> 2; kb = q2 & 3; woff = W_D; drow0 = (size_t)e * 1024 + nb * 64; Kd = 256; }
    else if ((r -= 16384) < 64) { f8 = true; W = inp(C, I_WSG) + (size_t)l * 1024 * 256; N = 256; nb = r >> 4; kb = r & 15; woff = W_GU; drow0 = (size_t)NE * 512 + (nb >> 1) * 256 + (nb & 1) * 64; Kd = 1024; }
    else if ((r -= 64) < 64) { f8 = true; W = inp(C, I_WSU) + (size_t)l * 1024 * 256; N = 256; nb = r >> 4; kb = r & 15; woff = W_GU; drow0 = (size_t)NE * 512 + (nb >> 1) * 256 + 128 + (nb & 1) * 64; Kd = 1024; }
    else { f8 = true; r -= 64; W = inp(C, I_WSD) + (size_t)l * 256 * 1024; N = 1024; nb = r >> 2; kb = r & 3; woff = W_D; drow0 = (size_t)NE * 1024 + nb * 64; Kd = 256; }
    TrItem t; t.src = W + (size_t)(kb * 64) * N + nb * 64 + C.lane; t.N = N; t.f8 = f8;
    t.dst = (unsigned char*)wl(C, l, woff) + ((drow0 + C.lane) * (size_t)Kd + koff + kb * 64) * (f8 ? 1 : 2);
    return t;
}
DI void tr_load(const TrItem& t, float (&v)[64]) {
#pragma unroll
    for (int i = 0; i < 64; ++i) v[i] = __builtin_nontemporal_load(t.src + (size_t)i * t.N);
}
DI void tr_store(const TrItem& t, const float (&v)[64]) {
    if (t.f8) {
#pragma unroll
        for (int c = 0; c < 4; ++c) { v4u w; w.x = pk4_fp8w(v[16 * c] * W8_SCALE, v[16 * c + 1] * W8_SCALE, v[16 * c + 2] * W8_SCALE, v[16 * c + 3] * W8_SCALE); w.y = pk4_fp8w(v[16 * c + 4] * W8_SCALE, v[16 * c + 5] * W8_SCALE, v[16 * c + 6] * W8_SCALE, v[16 * c + 7] * W8_SCALE);
            w.z = pk4_fp8w(v[16 * c + 8] * W8_SCALE, v[16 * c + 9] * W8_SCALE, v[16 * c + 10] * W8_SCALE, v[16 * c + 11] * W8_SCALE); w.w = pk4_fp8w(v[16 * c + 12] * W8_SCALE, v[16 * c + 13] * W8_SCALE, v[16 * c + 14] * W8_SCALE, v[16 * c + 15] * W8_SCALE); *(v4u*)(t.dst + 16 * c) = w; }
    } else {
#pragma unroll
        for (int c = 0; c < 8; ++c) { v4u w; w.x = pk2(v[8 * c], v[8 * c + 1]); w.y = pk2(v[8 * c + 2], v[8 * c + 3]); w.z = pk2(v[8 * c + 4], v[8 * c + 5]); w.w = pk2(v[8 * c + 6], v[8 * c + 7]); *(v4u*)(t.dst + 16 * c) = w; }
    }
}
DI void p0_transposes(const Ctx& C) {
    unsigned* q = (unsigned*)(C.ws + WS_CTL) + CW_TRQ;
    for (;;) {
        int base = 0; if (C.lane == 0) base = (int)__hip_atomic_fetch_add(q, 16u, RLX_AGENT);
        base = __builtin_amdgcn_readfirstlane(base);
        if (base >= DEPTH * TR_PER_LAYER) break;
        float va[64], vb[64];
        TrItem ta = tr_decode(C, base), tb; tr_load(ta, va);
        for (int j = 0; j < 16; j += 2) {
            tb = tr_decode(C, base + j + 1); tr_load(tb, vb);
            tr_store(ta, va);
            if (j + 2 < 16) { ta = tr_decode(C, base + j + 2); tr_load(ta, va); }
            tr_store(tb, vb);
        }
    }
}
DI void p0_mod(const Ctx& C) {
    LAS float* sil = (LAS float*)C.lds; LAS float* red = sil + 9 * 1024;
    for (int i = C.tid; i < 9 * 1024; i += 512) { const int bi = i >> 10, k = i & 1023; const float c = bi < 8 ? inp(C, I_C)[bi * 1024 + k] : inp(C, I_CCTX)[k]; sil[i] = c * sigm(c); }
    __syncthreads();
    const int j = C.bid * 64 + C.lane, l = j / 6144, col = j - l * 6144, k0 = C.wave * 128;
    float acc[9];
#pragma unroll
    for (int bi = 0; bi < 9; ++bi) acc[bi] = 0.f;
    const float* w = inp(C, I_WADA) + (size_t)l * 1024 * 6144 + col;
#pragma unroll 16
    for (int k = k0; k < k0 + 128; ++k) { const float wv = w[(size_t)k * 6144];
#pragma unroll
        for (int bi = 0; bi < 9; ++bi) acc[bi] += sil[bi * 1024 + k] * wv; }
#pragma unroll
    for (int bi = 0; bi < 9; ++bi) red[(C.wave * 9 + bi) * 64 + C.lane] = acc[bi];
    __syncthreads();
    if (C.wave == 0) { float* mo = wsf(C, WS_MOD); const float b0 = inp(C, I_BADA)[l * 6144 + col];
#pragma unroll
        for (int bi = 0; bi < 9; ++bi) { float s = b0;
#pragma unroll
            for (int wv = 0; wv < 8; ++wv) s += red[(wv * 9 + bi) * 64 + C.lane];
            mo[(size_t)(l * 9 + bi) * 6144 + col] = s; } }
    __syncthreads();
}
DI void p0_tables(const Ctx& C) {
    bf16* cs = wsb(C, WS_CS64); float* tw = wsf(C, WS_TW);
    for (int i = C.tid; i < 8192; i += 512) { const int r = i >> 7, j = i & 127, jj = j & 63; float s, c; sincospif((float)((r * jj) & 63) * (1.0f / 32.0f), &s, &c); cs[i] = (bf16)f2bf(j < 64 ? c : s); }
    for (int i = C.tid; i < 4096; i += 512) { const int k1 = i >> 6, n2 = i & 63; float s, c; sincospif((float)(k1 * n2) * (1.0f / 2048.0f), &s, &c); tw[2 * i] = c; tw[2 * i + 1] = s; }
    bf16* c2 = wsb(C, WS_CS256);
    for (int i = C.tid; i < 256 * 256; i += 512) { const int k = i >> 8, n = i & 255; float s, c; sincospif((float)((k * n) & 255) * (1.0f / 128.0f), &s, &c); c2[k * 512 + n] = (bf16)f2bf(c); c2[k * 512 + 256 + n] = (bf16)f2bf(s); }
}
struct NRow { f32x4 x[4], sc[4], sh[4]; };
template <bool SRC_F32> DI void nrow_issue(const Ctx& C, const void* xl, const void* xc, int l, int m_sh, int m_sc, int row, NRow& R) {
    const int bi = row < NLAT ? (row >> 12) : 8;
    const float* sh = modp(C, l, bi, m_sh); const float* sc = modp(C, l, bi, m_sc);
#pragma unroll
    for (int j = 0; j < 2; ++j) { const int col = 8 * C.lane + 512 * j;
        if (SRC_F32) { const float* xr = row < NLAT ? (const float*)xl + (size_t)row * D : (const float*)xc + (size_t)(row - NLAT) * D; R.x[2 * j] = *(const f32x4*)(xr + col); R.x[2 * j + 1] = *(const f32x4*)(xr + col + 4); }
        else { const bf16* xr = (const bf16*)xl + (size_t)row * D; const v4u w = *(const v4u*)(xr + col); R.x[2 * j] = (f32x4){bflo(w.x), bfhi(w.x), bflo(w.y), bfhi(w.y)}; R.x[2 * j + 1] = (f32x4){bflo(w.z), bfhi(w.z), bflo(w.w), bfhi(w.w)}; }
        R.sc[2 * j] = *(const f32x4*)(sc + col); R.sc[2 * j + 1] = *(const f32x4*)(sc + col + 4); R.sh[2 * j] = *(const f32x4*)(sh + col); R.sh[2 * j + 1] = *(const f32x4*)(sh + col + 4); }
}
template <bool SRC_F32> DI void norm_mod_rows(const Ctx& C, const void* xl, const void* xc, const float* gain, int l, int m_sh, int m_sc, bf16* H, unsigned char* H8, int nrows) {
    const int gw = C.bid * NWAVES + C.wave, NGW = C.G * NWAVES;
    if (gw >= nrows) return;
    f32x4 g[4];
#pragma unroll
    for (int j = 0; j < 2; ++j) { g[2 * j] = *(const f32x4*)(gain + 8 * C.lane + 512 * j); g[2 * j + 1] = *(const f32x4*)(gain + 8 * C.lane + 512 * j + 4); }
    NRow Rn = {}; nrow_issue<SRC_F32>(C, xl, xc, l, m_sh, m_sc, gw, Rn);
    for (int row = gw; row < nrows; row += NGW) {
        const NRow Rc = Rn;
        if (row + NGW < nrows) nrow_issue<SRC_F32>(C, xl, xc, l, m_sh, m_sc, row + NGW, Rn);
        float ss = 0.f;
#pragma unroll
        for (int j = 0; j < 4; ++j) ss += (Rc.x[j].x * Rc.x[j].x + Rc.x[j].y * Rc.x[j].y) + (Rc.x[j].z * Rc.x[j].z + Rc.x[j].w * Rc.x[j].w);
        const float rstd = rsqrtf(wave_sum(ss, C.lane) * (1.0f / D) + RMS_EPS);
#pragma unroll
        for (int j = 0; j < 2; ++j) { const int col = 8 * C.lane + 512 * j;
            const f32x4 y0 = Rc.x[2 * j] * rstd * g[2 * j] * (Rc.sc[2 * j] + 1.0f) + Rc.sh[2 * j], y1 = Rc.x[2 * j + 1] * rstd * g[2 * j + 1] * (Rc.sc[2 * j + 1] + 1.0f) + Rc.sh[2 * j + 1];
            if (H) { v4u w; w.x = pk2(y0.x, y0.y); w.y = pk2(y0.z, y0.w); w.z = pk2(y1.x, y1.y); w.w = pk2(y1.z, y1.w); *(v4u*)(H + (size_t)row * D + col) = w; }
            if (H8) { v2u w; w.x = pk4_fp8(y0.x, y0.y, y0.z, y0.w); w.y = pk4_fp8(y1.x, y1.y, y1.z, y1.w); *(v2u*)(H8 + (size_t)row * D + col) = w; } }
    }
}

constexpr int L_CS = 0;
constexpr int L_S0 = 20480;
constexpr int P72 = 72, P136 = 136;
DI void load_cs_table(const Ctx& C) {
    const bf16* cs = wsb(C, WS_CS64); LAS bf16* d = (LAS bf16*)(C.lds + L_CS);
    v4u t[2];
#pragma unroll
    for (int j = 0; j < 2; ++j) { const int i = C.tid + 512 * j, r = i >> 4, c8 = i & 15; t[j] = *(const v4u*)(cs + r * 128 + c8 * 8); }
#pragma unroll
    for (int j = 0; j < 2; ++j) { const int i = C.tid + 512 * j, r = i >> 4, c8 = i & 15; *(LAS v4u*)(d + r * P136 + c8 * 8) = t[j]; }
}
DI void slab_put(LAS bf16* slab, const bf16* rowp_chunk, int lane) { *(LAS v4u*)(slab + (lane >> 3) * 72 + (lane & 7) * 8) = *(const v4u*)rowp_chunk; }
DI unsigned slab_get(const LAS bf16* slab, int i, int lane) { return slab[i * 72 + lane]; }
DI void vt_decode(const Ctx& C, int u, int& b, int& h, int& row0, bf16*& dst) {
    const int d = C.lane, seg = C.wave;
    if (u < 4096) { b = u >> 9; h = (u >> 6) & 7; const int tb = u & 63; row0 = b * SEQ + tb * 64; dst = wsb(C, WS_VTL) + ((size_t)((b * 8 + h) * 64 + d)) * SEQ + tb * 64 + seg * 8; }
    else { const int uc = u - 4096; b = uc >> 5; h = (uc >> 2) & 7; const int tb = uc & 3; row0 = NLAT + b * CTXL + tb * 64; dst = wsb(C, WS_VTC) + ((size_t)((b * 8 + h) * 64 + d)) * CTXL + tb * 64 + seg * 8; }
}
DI void vt_load(const Ctx& C, int u, v4u (&r)[1]) {
    int b, h, row0; bf16* dst; vt_decode(C, u, b, h, row0, dst);
    r[0] = *(const v4u*)(wsb(C, WS_Z) + (size_t)(row0 + C.wave * 8 + (C.lane >> 3)) * INC + C_V + h * 64 + (C.lane & 7) * 8);
}
DI void vt_unit(const Ctx& C, int u, const v4u (&r)[1]) {
    const int d = C.lane, seg = C.wave;
    int b, h, row0; bf16* dst; vt_decode(C, u, b, h, row0, dst);
    LAS bf16* slab = (LAS bf16*)(C.lds + L_S0 + 94208) + seg * 576;
    *(LAS v4u*)(slab + (d >> 3) * 72 + (d & 7) * 8) = r[0];
    unsigned v[8];
#pragma unroll
    for (int i = 0; i < 8; ++i) v[i] = slab_get(slab, i, d);
    v4u w; w.x = v[0] | (v[1] << 16); w.y = v[2] | (v[3] << 16); w.z = v[4] | (v[5] << 16); w.w = v[6] | (v[7] << 16);
    *(v4u*)dst = w;
}
DI void fft1_load(const Ctx& C, int u, v4u (&r)[1]) {
    const int b = u >> 8, g = (u >> 6) & 3, n2 = u & 63, lane = C.lane, w = C.wave;
    r[0] = *(const v4u*)(wsb(C, WS_Z) + (size_t)(b * SEQ + (w * 8 + (lane >> 3)) * 64 + n2) * INC + C_FN + g * 64 + (lane & 7) * 8);
}
template <int PART> DI void fft1_unit(const Ctx& C, int u, const v4u (&r)[1]) {
    const int b = u >> 8, g = (u >> 6) & 3, n2 = u & 63, lane = C.lane, w = C.wave, fr = lane & 15, fq = lane >> 4;
    const bf16* Z = wsb(C, WS_Z); LAS bf16* UT = (LAS bf16*)(C.lds + L_S0 + 53248); const LAS bf16* CS = (const LAS bf16*)(C.lds + L_CS);
    if (PART == 0) __syncthreads();
    if (PART != 2) { LAS bf16* slab = (LAS bf16*)(C.lds + L_S0 + 63488) + w * 576; unsigned v[8];
      *(LAS v4u*)(slab + (lane >> 3) * 72 + (lane & 7) * 8) = r[0];
#pragma unroll
      for (int i = 0; i < 8; ++i) v[i] = slab_get(slab, i, lane);
      v4u x; x.x = v[0] | (v[1] << 16); x.y = v[2] | (v[3] << 16); x.z = v[4] | (v[5] << 16); x.w = v[6] | (v[7] << 16);
      *(LAS v4u*)(UT + lane * P72 + w * 8) = x; }
    if (PART == 0) __syncthreads();
    if (PART == 1) return;
    const int kt = w >> 1, k1 = kt * 16 + fr;
    const float* tw = wsf(C, WS_TW) + 2 * (k1 * 64 + n2); const float tc = tw[0], ts = tw[1];
    bf16* t1r = wsb(C, WS_T1R) + ((size_t)((b * 4 + g) * 64 + k1)) * 4096 + n2 * 64; bf16* t1i = wsb(C, WS_T1I) + ((size_t)((b * 4 + g) * 64 + k1)) * 4096 + n2 * 64;
#pragma unroll
    for (int ci = 0; ci < 2; ++ci) { const int ct = 2 * (w & 1) + ci; f32x4 aR = {0.f, 0.f, 0.f, 0.f}, aI = {0.f, 0.f, 0.f, 0.f};
#pragma unroll
        for (int ks = 0; ks < 2; ++ks) { const bf16x8 a = ldfrag(UT, P72, ct * 16, ks * 32, lane), bc = ldfrag(CS, P136, kt * 16, ks * 32, lane), bs = ldfrag(CS, P136, kt * 16, 64 + ks * 32, lane);
            aR = mfma16(a, bc, aR); aI = mfma16(a, bs, aI); }
        const f32x4 re = aR * tc - aI * ts, im = -(aI * tc) - aR * ts;
        v2u x; x.x = pk2(re[0], re[1]); x.y = pk2(re[2], re[3]); *(v2u*)(t1r + ct * 16 + 4 * fq) = x;
        v2u y; y.x = pk2(im[0], im[1]); y.y = pk2(im[2], im[3]); *(v2u*)(t1i + ct * 16 + 4 * fq) = y; }
}
DI void fft2_load(const Ctx& C, int u, v4u (&r)[2]) {
    const int b = u >> 8, g = (u >> 6) & 3, k1 = u & 63, lane = C.lane, w = C.wave;
    const size_t base = ((size_t)((b * 4 + g) * 64 + k1)) * 4096 + (size_t)(w * 8 + (lane >> 3)) * 64 + (lane & 7) * 8;
    r[0] = *(const v4u*)(wsb(C, WS_T1R) + base); r[1] = *(const v4u*)(wsb(C, WS_T1I) + base);
}
DI void fft2_unit(const Ctx& C, int u, const v4u (&r)[2]) {
    const int b = u >> 8, g = (u >> 6) & 3, k1 = u & 63, lane = C.lane, w = C.wave, fr = lane & 15, fq = lane >> 4;
    LAS bf16* BR = (LAS bf16*)(C.lds + L_S0); LAS bf16* BI = BR + 64 * P136; LAS bf16* PP = BI + 64 * P136; const LAS bf16* CS = (const LAS bf16*)(C.lds + L_CS);
    __syncthreads();
    { unsigned rr[8], m[8];
      LAS bf16* slr = (LAS bf16*)(C.lds + L_S0 + 53248) + w * 576; LAS bf16* sli = slr + 8 * 576;
      *(LAS v4u*)(slr + (lane >> 3) * 72 + (lane & 7) * 8) = r[0]; *(LAS v4u*)(sli + (lane >> 3) * 72 + (lane & 7) * 8) = r[1];
#pragma unroll
      for (int i = 0; i < 8; ++i) { rr[i] = slab_get(slr, i, lane); m[i] = slab_get(sli, i, lane); }
      v4u xr, xi, xn; xr.x = rr[0] | (rr[1] << 16); xr.y = rr[2] | (rr[3] << 16); xr.z = rr[4] | (rr[5] << 16); xr.w = rr[6] | (rr[7] << 16);
      xi.x = m[0] | (m[1] << 16); xi.y = m[2] | (m[3] << 16); xi.z = m[4] | (m[5] << 16); xi.w = m[6] | (m[7] << 16);
      xn = xr ^ 0x80008000u;
      *(LAS v4u*)(BR + lane * P136 + w * 8) = xr; *(LAS v4u*)(BR + lane * P136 + 64 + w * 8) = xi;
      *(LAS v4u*)(BI + lane * P136 + w * 8) = xi; *(LAS v4u*)(BI + lane * P136 + 64 + w * 8) = xn; }
    __syncthreads();
    const int kt = w >> 1;
#pragma unroll
    for (int ci = 0; ci < 2; ++ci) { const int ct = 2 * (w & 1) + ci; f32x4 aR = {0.f, 0.f, 0.f, 0.f}, aI = {0.f, 0.f, 0.f, 0.f};
#pragma unroll
        for (int ks = 0; ks < 4; ++ks) { const bf16x8 bq = ldfrag(CS, P136, kt * 16, ks * 32, lane); aR = mfma16(ldfrag(BR, P136, ct * 16, ks * 32, lane), bq, aR); aI = mfma16(ldfrag(BI, P136, ct * 16, ks * 32, lane), bq, aI); }
        v2u x; x.x = pk2(aR[0], aR[1]); x.y = pk2(aR[2], aR[3]); *(LAS v2u*)(PP + (kt * 16 + fr) * P136 + ct * 16 + 4 * fq) = x;
        v2u y; y.x = pk2(aI[0], aI[1]); y.y = pk2(aI[2], aI[3]); *(LAS v2u*)(PP + (kt * 16 + fr) * P136 + 64 + ct * 16 + 4 * fq) = y; }
    __syncthreads();
    bf16* MIX = wsb(C, WS_MIX);
#pragma unroll
    for (int mi = 0; mi < 2; ++mi) { const int mt = 2 * (w & 1) + mi; f32x4 a = {0.f, 0.f, 0.f, 0.f};
#pragma unroll
        for (int ks = 0; ks < 4; ++ks) a = mfma16(ldfrag(CS, P136, mt * 16, ks * 32, lane), ldfrag(PP, P136, kt * 16, ks * 32, lane), a);
        a = a * (1.0f / 512.0f); const int k2 = kt * 16 + fr;
        *(unsigned*)((unsigned char*)MIX + (size_t)(b * SEQ + k1 + 64 * k2) * D + g * 64 + mt * 16 + 4 * fq) = pk4_fp8(a[0], a[1], a[2], a[3]); }
}
DI void cfft_unit(const Ctx& C, int u) {
    const int b = u >> 4, g = (u >> 2) & 3, kblk = u & 3, lane = C.lane, w = C.wave, fr = lane & 15, fq = lane >> 4;
    LAS bf16* UT = (LAS bf16*)(C.lds + L_S0); LAS bf16* PP = UT + 64 * 264; const LAS bf16* CS = (const LAS bf16*)(C.lds + L_CS);
    LAS bf16* slab = (LAS bf16*)(C.lds + L_S0 + 53248) + w * 576;
    const bf16* Z = wsb(C, WS_Z) + (size_t)(NLAT + b * CTXL) * INC + C_FN + g * 64;
    __syncthreads();
    v4u zz[4];
#pragma unroll
    for (int p = 0; p < 4; ++p) zz[p] = *(const v4u*)(Z + (size_t)(p * 64 + w * 8 + (lane >> 3)) * INC + (lane & 7) * 8);
#pragma unroll
    for (int p = 0; p < 4; ++p) { *(LAS v4u*)(slab + (lane >> 3) * 72 + (lane & 7) * 8) = zz[p]; unsigned v[8];
#pragma unroll
        for (int i = 0; i < 8; ++i) v[i] = slab_get(slab, i, lane);
        v4u x; x.x = v[0] | (v[1] << 16); x.y = v[2] | (v[3] << 16); x.z = v[4] | (v[5] << 16); x.w = v[6] | (v[7] << 16);
        *(LAS v4u*)(UT + lane * 264 + p * 64 + w * 8) = x; }
    __syncthreads();
    const int kt = w >> 1; const bf16* frow = wsb(C, WS_CS256) + (size_t)(kblk * 64 + kt * 16 + fr) * 512 + 8 * fq;
#pragma unroll
    for (int ci = 0; ci < 2; ++ci) { const int ct = 2 * (w & 1) + ci; f32x4 aR = {0.f, 0.f, 0.f, 0.f}, aI = {0.f, 0.f, 0.f, 0.f};
#pragma unroll
        for (int ks = 0; ks < 8; ++ks) { const bf16x8 a = ldfrag(UT, 264, ct * 16, ks * 32, lane); aR = mfma16(a, *(const bf16x8*)(frow + ks * 32), aR); aI = mfma16(a, *(const bf16x8*)(frow + 256 + ks * 32), aI); }
        const f32x4 nI = -aI;
        v2u x; x.x = pk2(aR[0], aR[1]); x.y = pk2(aR[2], aR[3]); *(LAS v2u*)(PP + (kt * 16 + fr) * P136 + ct * 16 + 4 * fq) = x;
        v2u y; y.x = pk2(nI[0], nI[1]); y.y = pk2(nI[2], nI[3]); *(LAS v2u*)(PP + (kt * 16 + fr) * P136 + 64 + ct * 16 + 4 * fq) = y; }
    __syncthreads();
    bf16* MIX = wsb(C, WS_MIX);
#pragma unroll
    for (int mi = 0; mi < 2; ++mi) { const int mt = 2 * (w & 1) + mi; f32x4 a = {0.f, 0.f, 0.f, 0.f};
#pragma unroll
        for (int ks = 0; ks < 4; ++ks) a = mfma16(ldfrag(CS, P136, mt * 16, ks * 32, lane), ldfrag(PP, P136, kt * 16, ks * 32, lane), a);
        a = a * (1.0f / 128.0f);
        *(unsigned*)((unsigned char*)MIX + (size_t)(NLAT + b * CTXL + kblk * 64 + kt * 16 + fr) * D + g * 64 + mt * 16 + 4 * fq) = pk4_fp8(a[0], a[1], a[2], a[3]); }
}
DI void cfft1_item(const Ctx& C, int it) {
    LAS float* tab = (LAS float*)(C.lds + L_S0);
    __syncthreads();
    if (C.tid < 256) { float s, c; sincospif((float)C.tid * (1.0f / 128.0f), &s, &c); tab[2 * C.tid] = c; tab[2 * C.tid + 1] = s; }
    __syncthreads();
    const int idx = it * 512 + C.tid, c = idx & 63, k = (idx >> 6) & 255, bg = idx >> 14, b = bg >> 2, g = bg & 3;
    const bf16* src = wsb(C, WS_Z) + (size_t)(NLAT + b * CTXL) * INC + C_FN + g * 64 + c;
    float pr = 0.f, pi = 0.f;
#pragma unroll 8
    for (int n = 0; n < 256; ++n) { const float uv = bf2f(src[(size_t)n * INC]); const int a = (k * n) & 255; pr += uv * tab[2 * a]; pi -= uv * tab[2 * a + 1]; }
    float* cp = wsf(C, WS_CP) + (size_t)idx * 2; cp[0] = pr; cp[1] = pi;
}
DI void cfft2_item(const Ctx& C, int it) {
    LAS float* tab = (LAS float*)(C.lds + L_S0 + 4096);
    __syncthreads();
    if (C.tid < 64) { float s, c; sincospif((float)C.tid * (1.0f / 32.0f), &s, &c); tab[2 * C.tid] = c; tab[2 * C.tid + 1] = s; }
    __syncthreads();
    const int idx = it * 512 + C.tid, m = idx & 63, k = (idx >> 6) & 255, bg = idx >> 14, b = bg >> 2, g = bg & 3;
    const float* cp = wsf(C, WS_CP) + (size_t)(idx - m) * 2; float y = 0.f;
#pragma unroll 8
    for (int c = 0; c < 64; ++c) { const int a = (m * c) & 63; y += cp[2 * c] * tab[2 * a] + cp[2 * c + 1] * tab[2 * a + 1]; }
    wsb(C, WS_MIX)[(size_t)(NLAT + b * CTXL + k) * D + g * 64 + m] = (bf16)f2bf(y * (1.0f / 128.0f));
}

DI int hg_row(int b, int p, int dir) { return dir == 0 ? (p < CTXL ? NLAT + b * CTXL + p : b * SEQ + (p - CTXL)) : (p < CTXL ? NLAT + b * CTXL + (CTXL - 1 - p) : b * SEQ + (SEQ - 1 - (p - CTXL))); }
DI float hg_lb(const Ctx& C, int l, int dir, int ch) {
    if (l == 0) return 0.f;
    const float v0 = inp(C, I_HGLB)[dir * 256 + ch], v1 = inp(C, I_HGLB)[512 + dir * 256 + ch];
    return 1.0f / (1.0f + __expf(v0 - v1));
}
DI void hgrn1_load(const Ctx& C, int u, v4u (&r)[2]) {
    const int chain = u / NCHUNK, c = u - chain * NCHUNK, b = chain >> 3, h = (chain >> 1) & 3, dir = chain & 1, lane = C.lane, w = C.wave;
    const size_t row = (size_t)hg_row(b, c * 64 + w * 8 + (lane >> 3), dir) * INC + h * 64 + (lane & 7) * 8; const bf16* Z = wsb(C, WS_Z);
    r[0] = *(const v4u*)(Z + row + (dir ? C_HB : C_HF)); r[1] = *(const v4u*)(Z + row + C_HI);
}
DI void hgrn1_unit(const Ctx& C, int l, int u, const v4u (&r)[2], bool do_f, int uf, const v4u (&rf)[1]) {
    const int chain = u / NCHUNK, c = u - chain * NCHUNK, b = chain >> 3, h = (chain >> 1) & 3, dir = chain & 1, lane = C.lane, w = C.wave, fr = lane & 15, fq = lane >> 4;
    const bf16* Z = wsb(C, WS_Z);
    LAS float* TOT = (LAS float*)(C.lds + L_S0); LAS bf16* KD = (LAS bf16*)(C.lds + L_S0 + 4096); LAS bf16* VT = KD + 64 * P72;
    const float lb = hg_lb(C, l, dir, h * 64 + lane);
    float f[8], cs[8]; unsigned vv[8]; float run = 0.f;
    LAS bf16* slz = (LAS bf16*)(C.lds + L_S0 + 32768) + w * 576; LAS bf16* slv = slz + 8 * 576;
    *(LAS v4u*)(slz + (lane >> 3) * 72 + (lane & 7) * 8) = r[0]; *(LAS v4u*)(slv + (lane >> 3) * 72 + (lane & 7) * 8) = r[1];
#pragma unroll
    for (int i = 0; i < 8; ++i) { const float z = bf2f(slab_get(slz, i, lane)); vv[i] = slab_get(slv, i, lane);
        f[i] = lb + (1.0f - lb) * sigm(z); run += __logf(f[i]); cs[i] = run; }
    __syncthreads();
    if (do_f) fft1_unit<1>(C, uf, rf);
    TOT[w * 64 + lane] = run;
    { v4u x; x.x = vv[0] | (vv[1] << 16); x.y = vv[2] | (vv[3] << 16); x.z = vv[4] | (vv[5] << 16); x.w = vv[6] | (vv[7] << 16); *(LAS v4u*)(VT + lane * P72 + w * 8) = x; }
    __syncthreads();
    if (do_f) fft1_unit<2>(C, uf, rf);
    float off = 0.f, blast = 0.f;
#pragma unroll
    for (int s = 0; s < 8; ++s) { const float t = TOT[s * 64 + lane]; blast += t; if (s < w) off += t; }
    float kd[8];
#pragma unroll
    for (int i = 0; i < 8; ++i) kd[i] = (1.0f - f[i]) * __expf(blast - (off + cs[i]));
    { v4u x; x.x = pk2(kd[0], kd[1]); x.y = pk2(kd[2], kd[3]); x.z = pk2(kd[4], kd[5]); x.w = pk2(kd[6], kd[7]); *(LAS v4u*)(KD + lane * P72 + w * 8) = x; }
    if (w == 0) wsf(C, WS_HDEC)[(size_t)u * 64 + lane] = __expf(blast);
    __syncthreads();
    const int vt = w >> 1; float* HL = wsf(C, WS_HL) + (size_t)u * 4096;
#pragma unroll
    for (int ki = 0; ki < 2; ++ki) { const int kt = 2 * (w & 1) + ki; f32x4 a = {0.f, 0.f, 0.f, 0.f};
#pragma unroll
        for (int ks = 0; ks < 2; ++ks) a = mfma16(ldfrag(KD, P72, kt * 16, ks * 32, lane), ldfrag(VT, P72, vt * 16, ks * 32, lane), a);
        *(f32x4*)(HL + (vt * 16 + fr) * 64 + kt * 16 + 4 * fq) = a; }
}
DI void hgrn2_item(const Ctx& C, int it) {
    const int idx = it * 512 + C.tid, chain = idx >> 12, vk = idx & 4095, k = vk & 63;
    const float* HL = wsf(C, WS_HL) + (size_t)chain * NCHUNK * 4096 + vk; const float* DEC = wsf(C, WS_HDEC) + (size_t)chain * NCHUNK * 64 + k; bf16* SP = wsb(C, WS_HSP) + (size_t)chain * NCHUNK * 4096 + vk;
    float S = 0.f;
    float hn[17], dn[17];
#pragma unroll
    for (int j = 0; j < 17; ++j) { hn[j] = HL[(size_t)j * 4096]; dn[j] = DEC[j * 64]; }
    for (int c0 = 0; c0 < NCHUNK; c0 += 17) {
        float hl[17], dc[17];
#pragma unroll
        for (int j = 0; j < 17; ++j) { hl[j] = hn[j]; dc[j] = dn[j]; }
        if (c0 + 17 < NCHUNK) {
#pragma unroll
            for (int j = 0; j < 17; ++j) { hn[j] = HL[(size_t)(c0 + 17 + j) * 4096]; dn[j] = DEC[(c0 + 17 + j) * 64]; } }
#pragma unroll
        for (int j = 0; j < 17; ++j) { SP[(size_t)(c0 + j) * 4096] = (bf16)f2bf(S); S = dc[j] * S + hl[j]; }
    }
}
DI void hgrn3_load(const Ctx& C, int u, v4u (&r)[4]) {
    const int cl = u % NCHUNK, bh = u / NCHUNK, b = bh >> 2, h = bh & 3, lane = C.lane, w = C.wave;
    const int row0 = cl >= 64 ? NLAT + b * CTXL + (cl - 64) * 64 : b * SEQ + cl * 64; const bf16* Z = wsb(C, WS_Z);
    const size_t row = (size_t)(row0 + w * 8 + (lane >> 3)) * INC + h * 64 + (lane & 7) * 8;
    r[0] = *(const v4u*)(Z + row + C_HF); r[1] = *(const v4u*)(Z + row + C_HB); r[2] = *(const v4u*)(Z + row + C_HQ); r[3] = *(const v4u*)(Z + row + C_HI);
}
DI void hgrn3_unit(const Ctx& C, int l, int u, const v4u (&r)[4]) {
    const int cl = u % NCHUNK, bh = u / NCHUNK, b = bh >> 2, h = bh & 3, lane = C.lane, w = C.wave, fr = lane & 15, fq = lane >> 4;
    const bool isctx = cl >= 64; const int cc = cl - 64;
    const int row0 = isctx ? NLAT + b * CTXL + cc * 64 : b * SEQ + cl * 64;
    const int cF = isctx ? cc : 4 + cl, cB = isctx ? 3 - cc : 4 + (63 - cl);
    const size_t uF = (size_t)(bh * 2) * NCHUNK + cF, uB = (size_t)(bh * 2 + 1) * NCHUNK + cB;
    const bf16* Z = wsb(C, WS_Z);
    unsigned char LAS* base = C.lds + L_S0;
    LAS float* TOTF = (LAS float*)base; LAS float* TOTB = (LAS float*)(base + 2048);
    LAS bf16* QtF = (LAS bf16*)(base + 4096); LAS bf16* KtF = QtF + 64 * P72; LAS bf16* QtB = KtF + 64 * P72; LAS bf16* KtB = QtB + 64 * P72;
    LAS bf16* QhF = KtB + 64 * P72; LAS bf16* QhB = QhF + 64 * P72; LAS bf16* VT = QhB + 64 * P72; LAS bf16* AA = VT + 64 * P72;
    LAS float* OO = (LAS float*)(AA + 64 * P72);
    const float lbF = hg_lb(C, l, 0, h * 64 + lane), lbB = hg_lb(C, l, 1, h * 64 + lane);
    float fF[8], fB[8], cF_[8], cB_[8], q[8]; unsigned vv[8];
    const bf16* SPF = wsb(C, WS_HSP) + uF * 4096; const bf16* SPB = wsb(C, WS_HSP) + uB * 4096;
    bf16x8 sfF[2][2], sfB[2][2];
#pragma unroll
    for (int vi = 0; vi < 2; ++vi)
#pragma unroll
        for (int ks = 0; ks < 2; ++ks) { const int vt = 2 * (w & 1) + vi; sfF[vi][ks] = *(const bf16x8*)(SPF + (vt * 16 + fr) * 64 + ks * 32 + 8 * fq); sfB[vi][ks] = *(const bf16x8*)(SPB + (vt * 16 + fr) * 64 + ks * 32 + 8 * fq); }
    const v4u hw = *(const v4u*)(Z + (size_t)(row0 + (C.tid >> 3)) * INC + C_HG + h * 64 + (C.tid & 7) * 8);
    const f32x4 g0 = *(const f32x4*)(inp(C, I_HGNG) + l * 64 + (C.tid & 7) * 8), g1 = *(const f32x4*)(inp(C, I_HGNG) + l * 64 + (C.tid & 7) * 8 + 4);
    __syncthreads();
    { LAS bf16* sl = AA + w * (4 * 576); const int so = (lane >> 3) * 72 + (lane & 7) * 8;
      *(LAS v4u*)(sl + so) = r[0]; *(LAS v4u*)(sl + 576 + so) = r[1]; *(LAS v4u*)(sl + 2 * 576 + so) = r[2]; *(LAS v4u*)(sl + 3 * 576 + so) = r[3];
#pragma unroll
      for (int i = 0; i < 8; ++i) { const float zf = bf2f(slab_get(sl, i, lane)), zb = bf2f(slab_get(sl + 576, i, lane)), hq = bf2f(slab_get(sl + 2 * 576, i, lane)); vv[i] = slab_get(sl + 3 * 576, i, lane);
        fF[i] = lbF + (1.0f - lbF) * sigm(zf); fB[i] = lbB + (1.0f - lbB) * sigm(zb); q[i] = hq * sigm(hq); } }
    { float run = 0.f;
#pragma unroll
      for (int i = 0; i < 8; ++i) { run += __logf(fF[i]); cF_[i] = run; }
      float runb = 0.f;
#pragma unroll
      for (int i = 7; i >= 0; --i) { runb += __logf(fB[i]); cB_[i] = runb; }
      TOTF[w * 64 + lane] = run; TOTB[w * 64 + lane] = runb; }
    { v4u x; x.x = vv[0] | (vv[1] << 16); x.y = vv[2] | (vv[3] << 16); x.z = vv[4] | (vv[5] << 16); x.w = vv[6] | (vv[7] << 16); *(LAS v4u*)(VT + lane * P72 + w * 8) = x; }
    __syncthreads();
    float offF = 0.f, offB = 0.f, mF = 0.f, mB = 0.f;
#pragma unroll
    for (int s = 0; s < 8; ++s) { const float tf = TOTF[s * 64 + lane], tb = TOTB[s * 64 + lane]; if (s < w) offF += tf; if (s > w) offB += tb; if (s < 4) mF += tf; else mB += tb; }
#pragma unroll
    for (int i = 0; i < 8; ++i) { const int t = w * 8 + i; const float bF = offF + cF_[i], bB = offB + cB_[i];
        QtF[t * P72 + lane] = (bf16)f2bf(q[i] * __expf(bF - mF)); KtF[t * P72 + lane] = (bf16)f2bf((1.0f - fF[i]) * __expf(mF - bF));
        QtB[t * P72 + lane] = (bf16)f2bf(q[i] * __expf(bB - mB)); KtB[t * P72 + lane] = (bf16)f2bf((1.0f - fB[i]) * __expf(mB - bB));
        QhF[t * P72 + lane] = (bf16)f2bf(q[i] * __expf(bF)); QhB[t * P72 + lane] = (bf16)f2bf(q[i] * __expf(bB)); }
    __syncthreads();
    const int tt = w >> 1, tau = tt * 16 + fr;
#pragma unroll
    for (int si = 0; si < 2; ++si) { const int st = 2 * (w & 1) + si; f32x4 aF = {0.f, 0.f, 0.f, 0.f}, aB = {0.f, 0.f, 0.f, 0.f};
#pragma unroll
        for (int ks = 0; ks < 2; ++ks) { aF = mfma16(ldfrag(KtF, P72, st * 16, ks * 32, lane), ldfrag(QtF, P72, tt * 16, ks * 32, lane), aF);
                                         aB = mfma16(ldfrag(KtB, P72, st * 16, ks * 32, lane), ldfrag(QtB, P72, tt * 16, ks * 32, lane), aB); }
        float o[4];
#pragma unroll
        for (int i = 0; i < 4; ++i) { const int sg = st * 16 + 4 * fq + i; o[i] = (sg <= tau ? aF[i] : 0.f) + (sg >= tau ? aB[i] : 0.f); }
        v2u x; x.x = pk2(o[0], o[1]); x.y = pk2(o[2], o[3]); *(LAS v2u*)(AA + tau * P72 + st * 16 + 4 * fq) = x; }
    __syncthreads();
#pragma unroll
    for (int vi = 0; vi < 2; ++vi) { const int vt = 2 * (w & 1) + vi; f32x4 a = {0.f, 0.f, 0.f, 0.f};
#pragma unroll
        for (int ks = 0; ks < 2; ++ks) { a = mfma16(ldfrag(VT, P72, vt * 16, ks * 32, lane), ldfrag(AA, P72, tt * 16, ks * 32, lane), a);
            a = mfma16(sfF[vi][ks], ldfrag(QhF, P72, tt * 16, ks * 32, lane), a);
            a = mfma16(sfB[vi][ks], ldfrag(QhB, P72, tt * 16, ks * 32, lane), a); }
        *(LAS f32x4*)(OO + tau * 68 + vt * 16 + 4 * fq) = a; }
    __syncthreads();
    { const int t = C.tid >> 3, part = C.tid & 7; const f32x4 o0 = *(const LAS f32x4*)(OO + t * 68 + part * 8), o1 = *(const LAS f32x4*)(OO + t * 68 + part * 8 + 4);
      float ss = (o0.x * o0.x + o0.y * o0.y) + (o0.z * o0.z + o0.w * o0.w) + (o1.x * o1.x + o1.y * o1.y) + (o1.z * o1.z + o1.w * o1.w);
      ss += shx(ss, 1, C.lane); ss += shx(ss, 2, C.lane); ss += shx(ss, 4, C.lane);
      const float rstd = rsqrtf(ss * (1.0f / 64.0f) + RMS_EPS);
      float hgv[8] = {bflo(hw.x), bfhi(hw.x), bflo(hw.y), bfhi(hw.y), bflo(hw.z), bfhi(hw.z), bflo(hw.w), bfhi(hw.w)};
      float y[8];
#pragma unroll
      for (int j = 0; j < 4; ++j) { y[j] = o0[j] * rstd * g0[j] * hgv[j] * sigm(hgv[j]); y[4 + j] = o1[j] * rstd * g1[j] * hgv[4 + j] * sigm(hgv[4 + j]); }
      v2u x; x.x = pk4_fp8(y[0], y[1], y[2], y[3]); x.y = pk4_fp8(y[4], y[5], y[6], y[7]);
      *(v2u*)(C.ws + WS_MIX + (size_t)(row0 + t) * D + 768 + h * 64 + part * 8) = x; }
}

template <bool LOCAL, bool CL> DI void attn_wave_unit(const Ctx& C, const LAS float* rpb, const LAS bf16* Kc, const LAS bf16* VTc, int b, int h, int r, int qg) {
    const int lane = C.lane, fr = lane & 15, fq = lane >> 4;
    const bf16* Z = wsb(C, WS_Z);
    const int qrow = LOCAL ? b * SEQ + r * 64 + qg * 16 + fr : NLAT + b * CTXL + qg * 16 + fr;
    const bf16* qp = Z + (size_t)qrow * INC + C_Q + h * 64 + 8 * fq;
    const bf16x8 q0 = *(const bf16x8*)qp, q1 = *(const bf16x8*)(qp + 32);
    const int kr0 = r < 4 ? 0 : (r > 60 ? 56 : r - 4);
    const int wbase = qg == 0 ? 0 : (qg == 1 ? 8 : (qg == 2 ? 24 : 32));
    const int keyc = 8 * (fr >> 2) + (fr & 3);
    f32x4 O[4]; float sum = 0.f;
#pragma unroll
    for (int dt = 0; dt < 4; ++dt) O[dt] = (f32x4){0.f, 0.f, 0.f, 0.f};
    bf16x8 kf[8][4];
    if (LOCAL) { const unsigned klane = (unsigned)(keyc * INC + 8 * fq);
#pragma unroll
      for (int kr = 0; kr < 4; ++kr) { const bf16* kp = (Z + (size_t)(b * SEQ + (kr0 + kr) * 64 + wbase) * INC + C_K + h * 64) + klane;
          kf[kr][0] = *(const bf16x8*)kp; kf[kr][1] = *(const bf16x8*)(kp + 32); kf[kr][2] = *(const bf16x8*)(kp + 4 * INC); kf[kr][3] = *(const bf16x8*)(kp + 4 * INC + 32); }
      __builtin_amdgcn_sched_barrier(0); }
    { bf16x8 P[8];
      const bf16* vtc = wsb(C, WS_VTC) + ((size_t)((b * 8 + h) * 64 + fr)) * CTXL + 8 * fq;
      bf16x8 kc[4];
      if (CL) { const LAS bf16* kp = Kc + keyc * 72 + 8 * fq; kc[0] = *(const LAS bf16x8*)kp; kc[1] = *(const LAS bf16x8*)(kp + 32); kc[2] = *(const LAS bf16x8*)(kp + 4 * 72); kc[3] = *(const LAS bf16x8*)(kp + 4 * 72 + 32); }
#pragma unroll
      for (int cb = 0; cb < 8; ++cb) { f32x4 s0 = {0.f, 0.f, 0.f, 0.f}, s1 = {0.f, 0.f, 0.f, 0.f};
          if (CL) { const bf16x8 k0 = kc[0], k1 = kc[1], k2 = kc[2], k3 = kc[3];
                    if (cb < 7) { const LAS bf16* kp = Kc + ((cb + 1) * 32 + keyc) * 72 + 8 * fq; kc[0] = *(const LAS bf16x8*)kp; kc[1] = *(const LAS bf16x8*)(kp + 32); kc[2] = *(const LAS bf16x8*)(kp + 4 * 72); kc[3] = *(const LAS bf16x8*)(kp + 4 * 72 + 32); }
                    __builtin_amdgcn_sched_barrier(0);
                    s0 = mfma16(k0, q0, s0); s0 = mfma16(k1, q1, s0); s1 = mfma16(k2, q0, s1); s1 = mfma16(k3, q1, s1); }
          else { const bf16* kp = Z + (size_t)(NLAT + b * CTXL + cb * 32 + keyc) * INC + C_K + h * 64 + 8 * fq; s0 = mfma16(*(const bf16x8*)kp, q0, s0); s0 = mfma16(*(const bf16x8*)(kp + 32), q1, s0);
                 s1 = mfma16(*(const bf16x8*)(kp + 4 * INC), q0, s1); s1 = mfma16(*(const bf16x8*)(kp + 4 * INC + 32), q1, s1); }
          float p[8];
#pragma unroll
          for (int i = 0; i < 4; ++i) { p[i] = __builtin_amdgcn_exp2f(fminf(s0[i] * (0.125f * LOG2E), 60.0f)); p[4 + i] = __builtin_amdgcn_exp2f(fminf(s1[i] * (0.125f * LOG2E), 60.0f)); }
#pragma unroll
          for (int i = 0; i < 8; ++i) sum += p[i];
          v4u x; x.x = pk2(p[0], p[1]); x.y = pk2(p[2], p[3]); x.z = pk2(p[4], p[5]); x.w = pk2(p[6], p[7]); P[cb] = __builtin_bit_cast(bf16x8, x); }
      if (LOCAL) { const unsigned klane = (unsigned)(keyc * INC + 8 * fq);
          __builtin_amdgcn_sched_barrier(0);
#pragma unroll
          for (int kr = 4; kr < 8; ++kr) { const bf16* kp = (Z + (size_t)(b * SEQ + (kr0 + kr) * 64 + wbase) * INC + C_K + h * 64) + klane;
              kf[kr][0] = *(const bf16x8*)kp; kf[kr][1] = *(const bf16x8*)(kp + 32); kf[kr][2] = *(const bf16x8*)(kp + 4 * INC); kf[kr][3] = *(const bf16x8*)(kp + 4 * INC + 32); }
          __builtin_amdgcn_sched_barrier(0); }
      if (CL) {
#pragma unroll
          for (int dt = 0; dt < 4; ++dt) { bf16x8 vc[8];
#pragma unroll
              for (int cb = 0; cb < 8; ++cb) vc[cb] = *(const LAS bf16x8*)(VTc + (dt * 16 + fr) * 264 + cb * 32 + 8 * fq);
              __builtin_amdgcn_sched_barrier(0);
#pragma unroll
              for (int cb = 0; cb < 8; ++cb) O[dt] = mfma16(vc[cb], P[cb], O[dt]);
              __builtin_amdgcn_sched_barrier(0); }
      } else {
#pragma unroll
      for (int dt = 0; dt < 4; ++dt)
#pragma unroll
          for (int cb = 0; cb < 8; ++cb) O[dt] = mfma16(*(const bf16x8*)(vtc + (size_t)dt * 16 * CTXL + cb * 32), P[cb], O[dt]); } }
    if (LOCAL) { bf16x8 P[8];
      __builtin_amdgcn_sched_barrier(0);
      const int qc = qg * 16 + fr; const int cs = qc < 8 ? 0 : (qc > 56 ? 48 : qc - 8);
      const bf16* vtlu = wsb(C, WS_VTL) + (size_t)((b * 8 + h) * 64) * SEQ + wbase; const unsigned vlane = (unsigned)(fr * SEQ + 8 * fq);
#pragma unroll
      for (int kr = 0; kr < 8; ++kr) {
          f32x4 s0 = {0.f, 0.f, 0.f, 0.f}, s1 = {0.f, 0.f, 0.f, 0.f};
          s0 = mfma16(kf[kr][0], q0, s0); s0 = mfma16(kf[kr][1], q1, s0); s1 = mfma16(kf[kr][2], q0, s1); s1 = mfma16(kf[kr][3], q1, s1);
          const int dr = kr0 + kr - r + 7; const LAS float* bp = rpb + h * 465 + dr * 31; float p[8];
#pragma unroll
          for (int i = 0; i < 4; ++i) {
              { const int kc = wbase + 8 * fq + i; const float ok = (kc >= cs && kc < cs + 16) ? 1.0f : 0.0f; int dc = kc - qc + 15; dc = dc < 0 ? 0 : (dc > 30 ? 30 : dc);
                p[i] = ok * __builtin_amdgcn_exp2f(fminf((s0[i] * 0.125f + bp[dc]) * LOG2E, 60.0f)); }
              { const int kc = wbase + 8 * fq + 4 + i; const float ok = (kc >= cs && kc < cs + 16) ? 1.0f : 0.0f; int dc = kc - qc + 15; dc = dc < 0 ? 0 : (dc > 30 ? 30 : dc);
                p[4 + i] = ok * __builtin_amdgcn_exp2f(fminf((s1[i] * 0.125f + bp[dc]) * LOG2E, 60.0f)); } }
#pragma unroll
          for (int i = 0; i < 8; ++i) sum += p[i];
          v4u x; x.x = pk2(p[0], p[1]); x.y = pk2(p[2], p[3]); x.z = pk2(p[4], p[5]); x.w = pk2(p[6], p[7]); P[kr] = __builtin_bit_cast(bf16x8, x); }
      __builtin_amdgcn_sched_barrier(0);
      bf16x8 vf[4][8];
#pragma unroll
      for (int dt = 0; dt < 4; ++dt)
#pragma unroll
          for (int kr = 0; kr < 8; ++kr) vf[dt][kr] = *(const bf16x8*)((vtlu + (size_t)dt * 16 * SEQ + (kr0 + kr) * 64) + vlane);
      __builtin_amdgcn_sched_barrier(0);
#pragma unroll
      for (int dt = 0; dt < 4; ++dt)
#pragma unroll
          for (int kr = 0; kr < 8; ++kr) O[dt] = mfma16(vf[dt][kr], P[kr], O[dt]); }
    sum += shx(sum, 16, lane); sum += shx(sum, 32, lane);
    const float inv = 1.0f / sum;
    unsigned w[4];
#pragma unroll
    for (int dt = 0; dt < 4; ++dt) { const f32x4 o = O[dt] * inv; w[dt] = pk4_fp8(o[0], o[1], o[2], o[3]); }
    const auto s01 = __builtin_amdgcn_permlane16_swap(w[0], w[1], false, false), s23 = __builtin_amdgcn_permlane16_swap(w[2], w[3], false, false);
    const auto t0 = __builtin_amdgcn_permlane32_swap(s01[0], s23[0], false, false), t1 = __builtin_amdgcn_permlane32_swap(s01[1], s23[1], false, false);
    v4u ov; ov.x = t0[0]; ov.y = t1[0]; ov.z = t0[1]; ov.w = t1[1];
    *(v4u*)(C.ws + WS_MIX + (size_t)qrow * D + 256 + h * 64 + 16 * fq) = ov;
}

DI void attn_phase(const Ctx& C, int l, bool with_ctx_queries) {
    const LAS float* rpb = (const LAS float*)(C.lds + 116096);
    if (C.G == 256) {
        LAS bf16* Kc = (LAS bf16*)(C.lds + L_S0); LAS bf16* VTc = Kc + 256 * 72;
        const int bh = C.bid >> 2, q = C.bid & 3, b = bh >> 3, h = bh & 7;
        __syncthreads();
        const bf16* Z = wsb(C, WS_Z); const bf16* vtc = wsb(C, WS_VTC) + (size_t)(bh * 64) * CTXL;
        v4u tk[4], tv[4];
#pragma unroll
        for (int i = 0; i < 4; ++i) { const int ch = C.tid + 512 * i, j = ch >> 3, c8 = ch & 7; tk[i] = *(const v4u*)(Z + (size_t)(NLAT + b * CTXL + j) * INC + C_K + h * 64 + c8 * 8); }
#pragma unroll
        for (int i = 0; i < 4; ++i) { const int ch = C.tid + 512 * i, d = ch >> 5, c8 = ch & 31; tv[i] = *(const v4u*)(vtc + (size_t)d * CTXL + c8 * 8); }
#pragma unroll
        for (int i = 0; i < 4; ++i) { const int ch = C.tid + 512 * i, j = ch >> 3, c8 = ch & 7; *(LAS v4u*)(Kc + j * 72 + c8 * 8) = tk[i]; }
#pragma unroll
        for (int i = 0; i < 4; ++i) { const int ch = C.tid + 512 * i, d = ch >> 5, c8 = ch & 31; *(LAS v4u*)(VTc + d * 264 + c8 * 8) = tv[i]; }
        __syncthreads();
        for (int u = C.wave; u < 64; u += NWAVES) attn_wave_unit<true, true>(C, rpb, Kc, VTc, b, h, 16 * q + (u >> 2), u & 3);
        if (with_ctx_queries && C.wave < 4) attn_wave_unit<false, true>(C, rpb, Kc, VTc, b, h, 0, 4 * q + C.wave);
    } else {
        const int gw = C.bid * NWAVES + C.wave, NGW = C.G * NWAVES;
        for (int wu = gw; wu < BATCH * 64 * 8 * 4; wu += NGW) { const int qg = wu & 3, h = (wu >> 2) & 7, r = (wu >> 5) & 63, b = wu >> 11; attn_wave_unit<true, false>(C, rpb, nullptr, nullptr, b, h, r, qg); }
        if (with_ctx_queries) for (int wu = gw; wu < BATCH * 8 * 16; wu += NGW) { const int qg = wu & 15, h = (wu >> 4) & 7, b = wu >> 7; attn_wave_unit<false, false>(C, rpb, nullptr, nullptr, b, h, 0, qg); }
    }
}

constexpr int L_RPB = 116096;

DI void topk_phase(const Ctx& C, int l, int nrow) {
    LAS unsigned* lcnt = (LAS unsigned*)C.lds; LAS unsigned* lbase = lcnt + 256; LAS float* lbias = (LAS float*)(lcnt + 512);
    LAS float* tile = (LAS float*)(C.lds + L_S0) + C.wave * (64 * 33);
    const int lane = C.lane;
    __syncthreads();
    if (C.tid < 256) { lcnt[C.tid] = 0u; lbias[C.tid] = inp(C, I_BR)[l * 256 + C.tid]; }
    __syncthreads();
    const int gw = C.bid * NWAVES + C.wave, NGW = C.G * NWAVES, nblk = nrow >> 6;
    const float* SC = wsf(C, WS_SC);
    for (int t = gw; t < nblk; t += NGW) {
        const int row0 = t * 64, row = row0 + lane;
        unsigned top[8];
#pragma unroll
        for (int k = 0; k < 8; ++k) top[k] = 0u;
        f32x4 vn[8];
#pragma unroll
        for (int i = 0; i < 8; ++i) vn[i] = *(const f32x4*)(SC + (size_t)(row0 + i * 8 + (lane >> 3)) * 256 + (lane & 7) * 4);
        for (int ch = 0; ch < 8; ++ch) {
            f32x4 v[8];
#pragma unroll
            for (int i = 0; i < 8; ++i) v[i] = vn[i];
            if (ch < 7) {
#pragma unroll
                for (int i = 0; i < 8; ++i) vn[i] = *(const f32x4*)(SC + (size_t)(row0 + i * 8 + (lane >> 3)) * 256 + (ch + 1) * 32 + (lane & 7) * 4); }
#pragma unroll
            for (int i = 0; i < 8; ++i) { LAS float* d = tile + (i * 8 + (lane >> 3)) * 33 + (lane & 7) * 4; d[0] = v[i][0]; d[1] = v[i][1]; d[2] = v[i][2]; d[3] = v[i][3]; }
#pragma unroll
            for (int j = 0; j < 32; ++j) { const float x = tile[lane * 33 + j]; const float sel = sigm(x) + lbias[ch * 32 + j] + 2.0f;
                unsigned key = (__float_as_uint(sel) & 0xFFFFFF00u) | (unsigned)(255 - (ch * 32 + j));
#pragma unroll
                for (int k = 0; k < 8; ++k) { const unsigned hi = key > top[k] ? key : top[k], lo = key > top[k] ? top[k] : key; top[k] = hi; key = lo; } }
        }
        int e[8]; float g[8]; float gsum = 0.f;
#pragma unroll
        for (int k = 0; k < 8; ++k) { e[k] = 255 - (int)(top[k] & 255u); g[k] = SC[(size_t)row * 256 + e[k]]; }
        __builtin_amdgcn_sched_barrier(0);
#pragma unroll
        for (int k = 0; k < 8; ++k) { g[k] = sigm(g[k]); gsum += g[k]; }
        const float sc = 2.5f / gsum; int pos[8];
#pragma unroll
        for (int k = 0; k < 8; ++k) pos[k] = (int)__hip_atomic_fetch_add(lcnt + e[k], 1u, __ATOMIC_RELAXED, __HIP_MEMORY_SCOPE_WORKGROUP);
        typedef int i32x4 __attribute__((ext_vector_type(4)));
        i32x4* pe = (i32x4*)(wsi(C, WS_TKE) + (size_t)row * 8); i32x4* pp = (i32x4*)(wsi(C, WS_TKP) + (size_t)row * 8); f32x4* pg = (f32x4*)(wsf(C, WS_TKG) + (size_t)row * 8);
        pe[0] = (i32x4){e[0], e[1], e[2], e[3]}; pe[1] = (i32x4){e[4], e[5], e[6], e[7]};
        pp[0] = (i32x4){pos[0], pos[1], pos[2], pos[3]}; pp[1] = (i32x4){pos[4], pos[5], pos[6], pos[7]};
        pg[0] = (f32x4){g[0] * sc, g[1] * sc, g[2] * sc, g[3] * sc}; pg[1] = (f32x4){g[4] * sc, g[5] * sc, g[6] * sc, g[7] * sc};
    }
    VM_WAIT(); __syncthreads();
    if (C.tid < 256) { const unsigned n = lcnt[C.tid]; lbase[C.tid] = n ? __hip_atomic_fetch_add((unsigned*)(C.ws + WS_CTL) + CW_CNT + (l * 256 + C.tid) * 64, n, RLX_AGENT) : 0u; }
    __syncthreads();
    for (int t = gw; t < nblk; t += NGW) { const size_t o = (size_t)(t * 64 + lane) * 8;
#pragma unroll
        for (int k = 0; k < 8; ++k) wsi(C, WS_TKP)[o + k] += (int)lbase[wsi(C, WS_TKE)[o + k]]; }
    __syncthreads();
}
DI int build_te(const Ctx& C, int l, LAS int* st_t, LAS int* st_s) {
    LAS unsigned short* TE = (LAS unsigned short*)(C.lds + TE_OFF + 16); LAS int* NTW = (LAS int*)(C.lds + TE_OFF); LAS int* wsum = st_s + 256;
    __syncthreads();
    int tl = 0;
    if (C.tid < 256) { const unsigned n = *((const unsigned*)(C.ws + WS_CTL) + CW_CNT + (l * 256 + C.tid) * 64); tl = (int)((n + 255u) >> 8); st_t[C.tid] = tl; }
    int v = tl;
#pragma unroll
    for (int o = 1; o < 64; o <<= 1) { const int u = __builtin_amdgcn_ds_bpermute((C.lane - o) << 2, v); if (C.lane >= o) v += u; }
    if (C.lane == 63 && C.wave < 4) wsum[C.wave] = v;
    __syncthreads();
    if (C.tid < 256) { int s = v - tl; for (int w = 0; w < C.wave; ++w) s += wsum[w]; st_s[C.tid] = s; for (int q = 0; q < tl; ++q) TE[s + q] = (unsigned short)C.tid; if (C.tid == 255) NTW[0] = s + tl; }
    __syncthreads();
    return NTW[0];
}
DI void route_slots(const Ctx& C, int l, int ntok) {
    LAS int* st_t = (LAS int*)C.lds; LAS int* st_s = st_t + 256;
    (void)build_te(C, l, st_t, st_s);
    int* stok = wsi(C, WS_STOK); float* sg = wsf(C, WS_SG) + T; int* tsl = wsi(C, WS_TSL);
    const int* tke = wsi(C, WS_TKE); const int* tkp = wsi(C, WS_TKP); const float* tkg = wsf(C, WS_TKG);
    for (int idx = C.bid * 512 + C.tid; idx < ntok * TOPK; idx += C.G * 512) { const int e = tke[idx], slot = st_s[e] * 256 + tkp[idx]; stok[slot] = idx >> 3; sg[slot] = tkg[idx]; tsl[idx] = slot; }
    for (int e = C.bid; e < NE; e += C.G) { const int n = (int)*((const unsigned*)(C.ws + WS_CTL) + CW_CNT + (l * 256 + e) * 64), hi = st_t[e] * 256;
        for (int s = n + C.tid; s < hi; s += 512) { stok[st_s[e] * 256 + s] = 0; sg[st_s[e] * 256 + s] = 0.f; } }
    __syncthreads();
}
template <int ncol, bool GATHER_> struct GroupedOrder {
    static constexpr bool GATHER = GATHER_;
    int nsh, ntile, G, c; const LAS unsigned short* TE; const int* stok;
    DI bool next(int i, pg8::Unit& u) const {
        const int total = ntile * ncol; int L;
        if ((G & 7) == 0) { const int x = c & 7, r = c >> 3, W = G >> 3, upx = (total + 7) >> 3;
            int q; if (ncol == 4) { const int upx2 = (upx + 1) & ~1; q = ((i >> 1) * W + r) * 2 + (i & 1); (void)upx2; }
            else q = i * W + r;
            if (q >= upx) return false; L = x * upx + q; }
        else L = i * G + c;
        if (L >= total) return false;
        const int ti = L / ncol, j = L - ti * ncol;
        if (ti < nsh) { u.pm = ti; u.pn = NE * ncol + j; } else { const int k = ti - nsh; u.pm = NSHT + k; u.pn = (int)TE[k] * ncol + j; }
        return true;
    }
    DI int arow(const pg8::Unit& u, int r) const { return (GATHER_ && u.pm >= NSHT) ? stok[(u.pm - NSHT) * 256 + r] : u.pm * 256 + r; }
    DI bool routed(const pg8::Unit& u) const { return GATHER_ && u.pm >= NSHT; }
    DI const int* rowlist(const pg8::Unit& u) const { return stok + (u.pm - NSHT) * 256; }
};
struct CRow { v2u y[9][2]; v4u x[2]; };
DI void crow_issue(const Ctx& C, int row, int myslot, CRow& R) {
    const unsigned char* Y = C.ws + WS_Y; const bf16* X = wsb(C, WS_X); const int lane = C.lane;
#pragma unroll
    for (int j = 0; j < 2; ++j) R.y[0][j] = *(const v2u*)(Y + (size_t)row * D + 8 * lane + 512 * j);
#pragma unroll
    for (int k = 0; k < TOPK; ++k) { const int slot = __builtin_amdgcn_readlane(myslot, k); const unsigned char* yr = Y + (size_t)(T + slot) * D + 8 * lane;
#pragma unroll
        for (int j = 0; j < 2; ++j) R.y[1 + k][j] = *(const v2u*)(yr + 512 * j); }
#pragma unroll
    for (int j = 0; j < 2; ++j) R.x[j] = *(const v4u*)(X + (size_t)row * D + 8 * lane + 512 * j);
}
DI void combine_rows(const Ctx& C, int l, int ntok) {
    const int gw = C.bid * NWAVES + C.wave, NGW = C.G * NWAVES, lane = C.lane;
    typedef float f32x2v __attribute__((ext_vector_type(2)));
    bf16* X = wsb(C, WS_X); const int* tsl = wsi(C, WS_TSL);
    const bool last = (l == DEPTH - 1);
    if (gw >= ntok) return;
    CRow Rn = {}; int s1 = 0, s2 = 0;
    { const int s0 = tsl[(size_t)gw * TOPK + (lane & 7)]; crow_issue(C, gw, s0, Rn); if (gw + NGW < ntok) s1 = tsl[(size_t)(gw + NGW) * TOPK + (lane & 7)]; }
    for (int row = gw; row < ntok; row += NGW) {
        const CRow Rc = Rn;
        if (row + NGW < ntok) crow_issue(C, row + NGW, s1, Rn);
        if (row + 2 * NGW < ntok) s2 = tsl[(size_t)(row + 2 * NGW) * TOPK + (lane & 7)];
        const int bi = row < NLAT ? (row >> 12) : 8;
        float a[2][8];
#pragma unroll
        for (int j = 0; j < 2; ++j)
#pragma unroll
            for (int i = 0; i < 8; ++i) a[j][i] = 0.f;
#pragma unroll
        for (int k = 0; k < 9; ++k)
#pragma unroll
            for (int j = 0; j < 2; ++j) { const v2u w = Rc.y[k][j];
                const f32x2v p0 = __builtin_amdgcn_cvt_pk_f32_fp8((int)w.x, false), p1 = __builtin_amdgcn_cvt_pk_f32_fp8((int)w.x, true), p2 = __builtin_amdgcn_cvt_pk_f32_fp8((int)w.y, false), p3 = __builtin_amdgcn_cvt_pk_f32_fp8((int)w.y, true);
                a[j][0] += p0.x; a[j][1] += p0.y; a[j][2] += p1.x; a[j][3] += p1.y; a[j][4] += p2.x; a[j][5] += p2.y; a[j][6] += p3.x; a[j][7] += p3.y; }
#pragma unroll
        for (int j = 0; j < 2; ++j)
#pragma unroll
            for (int i = 0; i < 8; ++i) a[j][i] *= (1.0f / 16.0f);
        const float* g2 = modp(C, l, bi, M_G2); float xn[2][8]; float ss = 0.f;
#pragma unroll
        for (int j = 0; j < 2; ++j) { const int col = 8 * lane + 512 * j; bf16* xp = X + (size_t)row * D + col;
            const v4u xw = Rc.x[j]; const f32x4 x0 = {bflo(xw.x), bfhi(xw.x), bflo(xw.y), bfhi(xw.y)}, x1 = {bflo(xw.z), bfhi(xw.z), bflo(xw.w), bfhi(xw.w)}, g0 = *(const f32x4*)(g2 + col), g1 = *(const f32x4*)(g2 + col + 4);
#pragma unroll
            for (int i = 0; i < 4; ++i) { xn[j][i] = x0[i] + g0[i] * a[j][i]; xn[j][4 + i] = x1[i] + g1[i] * a[j][4 + i]; }
#pragma unroll
            for (int i = 0; i < 8; ++i) ss += xn[j][i] * xn[j][i];
            if (!last) { v4u w; w.x = pk2(xn[j][0], xn[j][1]); w.y = pk2(xn[j][2], xn[j][3]); w.z = pk2(xn[j][4], xn[j][5]); w.w = pk2(xn[j][6], xn[j][7]); *(v4u*)xp = w; } }
        const float rstd = rsqrtf(wave_sum(ss, C.lane) * (1.0f / D) + RMS_EPS);
        if (!last) {
            const float* gn = inp(C, I_N1G) + (l + 1) * D; const float* sh = modp(C, l + 1, bi, M_SH1); const float* sc = modp(C, l + 1, bi, M_SC1); unsigned char* H8 = C.ws + WS_H8;
#pragma unroll
            for (int j = 0; j < 2; ++j) { const int col = 8 * lane + 512 * j; float y[8];
#pragma unroll
                for (int i = 0; i < 8; ++i) y[i] = xn[j][i] * rstd * gn[col + i] * (1.0f + sc[col + i]) + sh[col + i];
                v2u w; w.x = pk4_fp8(y[0], y[1], y[2], y[3]); w.y = pk4_fp8(y[4], y[5], y[6], y[7]); *(v2u*)(H8 + (size_t)row * D + col) = w; }
        } else {
            const float* gn = inp(C, I_FG);
#pragma unroll
            for (int j = 0; j < 2; ++j) { const int col = 8 * lane + 512 * j; float* op = C.out + (size_t)row * D + col;
                *(f32x4*)op = (f32x4){xn[j][0] * rstd * gn[col], xn[j][1] * rstd * gn[col + 1], xn[j][2] * rstd * gn[col + 2], xn[j][3] * rstd * gn[col + 3]};
                *(f32x4*)(op + 4) = (f32x4){xn[j][4] * rstd * gn[col + 4], xn[j][5] * rstd * gn[col + 5], xn[j][6] * rstd * gn[col + 6], xn[j][7] * rstd * gn[col + 7]}; }
        }
        s1 = s2;
    }
}

constexpr int SPL = 13;
constexpr int N_STEPS = 2 + SPL * DEPTH;
__global__ void __launch_bounds__(NWAVES * 64, 2) fwd_kernel(Args args) {
    extern __shared__ __attribute__((aligned(16))) unsigned char lds_raw[];
    Ctx C;
#pragma unroll
    for (int i = 0; i < 25; ++i) C.in[i] = args.in[i];
    unsigned char* const ws0 = args.ws; float* const out0 = args.out;
    C.z = 0; C.out = out0; C.ws = ws0; C.lds = (LAS unsigned char*)lds_raw;
    const int wv0 = __builtin_amdgcn_readfirstlane((int)threadIdx.x >> 6);
#define TIDX() ({ int l_; asm volatile("v_mbcnt_lo_u32_b32 %0, -1, 0\n\tv_mbcnt_hi_u32_b32 %0, -1, %0" : "=v"(l_)); wv0 * 64 + l_; })
    C.tid = TIDX(); C.lane = C.tid & 63; C.wave = wv0; C.bid = blockIdx.x; C.G = gridDim.x;
    for (int u = C.tid; u < (LDS_BYTES - LDSCTL_OFF) / 4; u += NWAVES * 64) ((LAS unsigned*)(C.lds + LDSCTL_OFF))[u] = 0u;
    __syncthreads();
    volatile LAS unsigned* MISC = (volatile LAS unsigned*)(C.lds + MISC_OFF);
    XcdBarrier bar = xcd_barrier_post((unsigned*)(C.ws + WS_CTL) + CW_BAR, MISC + 8, TIDX() == 0);
    const int lo = args.ph_lo, hi = args.ph_hi;
    float sc8;
#ifndef PHMASK
#define PHMASK 0xFFFFFFFFu
#endif
#ifndef REPMASK
#define REPMASK 0u
#endif
#define NREP(k) ((((REPMASK) >> (k)) & 1u) ? 2 : 1)
#define PHK(k) (((PHMASK) >> (k)) & 1u)
#define IN(k) (PHK((k) < 2 ? (k) : 2 + (((k) - 2) % SPL)) && lo <= (k) && (k) < hi)
#define SEAM(k) do { if (IN(k) && IN((k) + 1)) xcd_barrier(bar, TIDX() == 0); } while (0)
#define PH_BEGIN() do { sc8 = 1.0f / W8_SCALE; asm volatile("" : "+s"(sc8)); int t_ = TIDX(); asm volatile("" : "+v"(t_)); C.tid = t_; C.lane = t_ & 63; C.wave = __builtin_amdgcn_readfirstlane(t_ >> 6); asm volatile("" : "+s"(C.bid), "+s"(C.G)); { size_t z_ = 0; asm volatile("" : "+s"(z_)); C.z = z_; C.ws = ws0 + z_; C.out = out0 + z_; } } while (0)

    if (IN(0)) for (int rep_ = 0; rep_ < NREP(0); ++rep_) { PH_BEGIN();
        if (C.bid < 192) p0_mod(C);
        if (C.bid == C.G - 1) p0_tables(C);
        p0_transposes(C);
    }
    SEAM(0);
    if (IN(1)) for (int rep_ = 0; rep_ < NREP(1); ++rep_) { PH_BEGIN(); norm_mod_rows<true>(C, inp(C, I_X), inp(C, I_CTX), inp(C, I_N1G), 0, M_SH1, M_SC1, nullptr, C.ws + WS_H8, T); }
    SEAM(1);

    for (int l = 0; l < DEPTH; ++l) {
        const int s0 = 2 + SPL * l; const bool last = (l == DEPTH - 1);
        const int nrow = last ? NLAT : T;
        if (IN(s0 + 0)) for (int rep_ = 0; rep_ < NREP(2); ++rep_) { PH_BEGIN();
            pg8::Gemm g{(const bf16*)(C.ws + WS_H8), wl(C, l, W_IN), D / 2, D / 2}; pg8::StaticOrder S; S.init(T, INC, C.G, C.bid);
            pg8::EpiBf16 E{wsb(C, WS_Z), INC, sc8, C.ws + WS_G8, C_BG / 256};
            pg8::gemm_phase<pg8::EpiBf16, pg8::StaticOrder, true, true>(C.lds, g, S, E, C.tid);
        }
        SEAM(s0 + 0);
        if (IN(s0 + 1)) for (int rep_ = 0; rep_ < NREP(3); ++rep_) { PH_BEGIN();
            load_cs_table(C);
            static_assert(64 * NCHUNK == 4096 + 256, "the V^T copy units pair one to one with the HGRN chunk-state units");
            { v4u pr[2] = {}, pv[1] = {}, pf[1] = {}; int u = C.bid; if (u < 64 * NCHUNK) { hgrn1_load(C, u, pr); vt_load(C, u, pv); } if (u < 2048) fft1_load(C, u, pf);
              for (; u < 64 * NCHUNK; u += C.G) { const v4u cr[2] = {pr[0], pr[1]}; const v4u cv[1] = {pv[0]}; const v4u cf[1] = {pf[0]};
                  if (u + C.G < 64 * NCHUNK) { hgrn1_load(C, u + C.G, pr); vt_load(C, u + C.G, pv); } if (u + C.G < 2048) fft1_load(C, u + C.G, pf);
                  vt_unit(C, u, cv); hgrn1_unit(C, l, u, cr, u < 2048, u, cf); } }
            __syncthreads();
        }
        SEAM(s0 + 1);
        if (IN(s0 + 2)) for (int rep_ = 0; rep_ < NREP(4); ++rep_) { PH_BEGIN();
            load_cs_table(C);
            { LAS float* rpb = (LAS float*)(C.lds + L_RPB); const float* src = inp(C, I_RPB) + (size_t)l * 8 * 465; float t[8];
#pragma unroll
              for (int j = 0; j < 8; ++j) { const int i = C.tid + 512 * j; t[j] = i < 8 * 465 ? src[i] : 0.f; }
#pragma unroll
              for (int j = 0; j < 8; ++j) { const int i = C.tid + 512 * j; if (i < 8 * 465) rpb[i] = t[j]; } }
            __syncthreads();
            for (int it = C.bid; it < 512; it += C.G) hgrn2_item(C, it);
            { v4u pr[2] = {}; int u = C.bid; if (u < 2048) fft2_load(C, u, pr); for (; u < 2048; u += C.G) { const v4u cr[2] = {pr[0], pr[1]}; if (u + C.G < 2048) fft2_load(C, u + C.G, pr); fft2_unit(C, u, cr); } }
            attn_phase(C, l, !last);
            __syncthreads();
        }
        SEAM(s0 + 2);
        if (IN(s0 + 3)) for (int rep_ = 0; rep_ < NREP(5); ++rep_) { PH_BEGIN();
            if (!last) {
                load_cs_table(C); __syncthreads();
                const int c0 = C.G >= 256 ? C.bid - 128 : C.bid; if (c0 >= 0) for (int u = c0; u < 128; u += C.G) cfft_unit(C, u);
                __syncthreads(); }
            { const int NU = last ? 32 * 64 : 32 * NCHUNK;
              v4u pr[4] = {}; int u = C.bid; if (u < NU) hgrn3_load(C, last ? (u >> 6) * NCHUNK + (u & 63) : u, pr);
              for (; u < NU; u += C.G) { const v4u cr[4] = {pr[0], pr[1], pr[2], pr[3]}; const int un = u + C.G; if (un < NU) hgrn3_load(C, last ? (un >> 6) * NCHUNK + (un & 63) : un, pr);
                  hgrn3_unit(C, l, last ? (u >> 6) * NCHUNK + (u & 63) : u, cr); } }
            __syncthreads();
        }
        SEAM(s0 + 3);
        if (IN(s0 + 4)) for (int rep_ = 0; rep_ < NREP(6); ++rep_) { PH_BEGIN();
            pg8::StaticOrder S; S.init(nrow, D, C.G, C.bid); bf16* const Z = wsb(C, WS_Z); bf16* const MIX = wsb(C, WS_MIX); bf16* const MG = wsb(C, WS_MG);
            const bf16* const MIX8 = (const bf16*)(C.ws + WS_MIX); (void)MIX;
            { pg8::Gemm g{MIX8, wl(C, l, W_FN), D / 2, D / 2}; pg8::EpiBranchCat E{MG, C.ws + WS_G8, D, 3072, sc8}; pg8::gemm_phase<pg8::EpiBranchCat, pg8::StaticOrder, true, true>(C.lds, g, S, E, C.tid); }
        }
        SEAM(s0 + 4);
        if (IN(s0 + 5)) for (int rep_ = 0; rep_ < NREP(7); ++rep_) { PH_BEGIN();
            bf16* const X = wsb(C, WS_X); pg8::Gemm g{wsb(C, WS_MG), wl(C, l, W_OUT), D / 2, D / 2}; pg8::StaticOrder S; S.init(nrow, D, C.G, C.bid);
            if (l == 0) { pg8::EpiResid<true> E{X, inp(C, I_X), inp(C, I_CTX), modp(C, l, 0, M_G1), NLAT, 6144, sc8}; pg8::gemm_phase<pg8::EpiResid<true>, pg8::StaticOrder, true, true>(C.lds, g, S, E, C.tid); }
            else { pg8::EpiResid<false> E{X, nullptr, nullptr, modp(C, l, 0, M_G1), NLAT, 6144, sc8}; pg8::gemm_phase<pg8::EpiResid<false>, pg8::StaticOrder, true, true>(C.lds, g, S, E, C.tid); }
        }
        SEAM(s0 + 5);
        if (IN(s0 + 6)) for (int rep_ = 0; rep_ < NREP(8); ++rep_) { PH_BEGIN(); norm_mod_rows<false>(C, wsb(C, WS_X), nullptr, inp(C, I_N2G) + l * D, l, M_SH2, M_SC2, wsb(C, WS_H), C.ws + WS_H8, nrow); }
        SEAM(s0 + 6);
        if (IN(s0 + 7)) for (int rep_ = 0; rep_ < NREP(9); ++rep_) { PH_BEGIN();
            pg8::Gemm g{wsb(C, WS_H), wl(C, l, W_R), D, D}; pg8::StaticOrder S; S.init(nrow, 256, C.G, C.bid);
            pg8::EpiF32 E{wsf(C, WS_SC), 256};
            pg8::gemm_phase<pg8::EpiF32, pg8::StaticOrder>(C.lds, g, S, E, C.tid);
        }
        SEAM(s0 + 7);
        if (IN(s0 + 8)) { PH_BEGIN(); topk_phase(C, l, nrow); }
        SEAM(s0 + 8);
        if (IN(s0 + 9)) for (int rep_ = 0; rep_ < NREP(11); ++rep_) { PH_BEGIN(); route_slots(C, l, nrow); }
        SEAM(s0 + 9);
        if (IN(s0 + 10)) for (int rep_ = 0; rep_ < NREP(12); ++rep_) { PH_BEGIN();
            LAS int* st_t = (LAS int*)C.lds; const int NT = build_te(C, l, st_t, st_t + 256);
            __syncthreads();
            GroupedOrder<2, true> S{nrow / 256, nrow / 256 + NT, C.G, C.bid, (const LAS unsigned short*)(C.lds + TE_OFF + 16), wsi(C, WS_STOK)};
            pg8::Gemm g{(const bf16*)(C.ws + WS_H8), wl(C, l, W_GU), D / 2, D / 2}; pg8::EpiGateUp E{wsb(C, WS_HS), wsf(C, WS_SG), T, sc8};
            pg8::gemm_phase<pg8::EpiGateUp, GroupedOrder<2, true>, true, true>(C.lds, g, S, E, C.tid);
        }
        SEAM(s0 + 10);
        if (IN(s0 + 11)) for (int rep_ = 0; rep_ < NREP(13); ++rep_) { PH_BEGIN();
            LAS int* st_t = (LAS int*)C.lds; const int NT = build_te(C, l, st_t, st_t + 256);
            __syncthreads();
            GroupedOrder<4, false> S{nrow / 256, nrow / 256 + NT, C.G, C.bid, (const LAS unsigned short*)(C.lds + TE_OFF + 16), nullptr};
            pg8::Gemm g{wsb(C, WS_HS), wl(C, l, W_D), 128, 128}; pg8::EpiDown E{C.ws + WS_Y};
            pg8::gemm_phase<pg8::EpiDown, GroupedOrder<4, false>, true, true>(C.lds, g, S, E, C.tid);
        }
        SEAM(s0 + 11);
        if (IN(s0 + 12)) for (int rep_ = 0; rep_ < NREP(14); ++rep_) { PH_BEGIN(); combine_rows(C, l, nrow); }
        if (!last) SEAM(s0 + 12);
    }
#undef IN
#undef SEAM
}

#ifndef MK_PER_STEP
#define MK_PER_STEP 0
#endif
extern "C" void kernel_launch(void* const* d_in, const int* in_sizes, int n_in, void* d_out, int out_size, void* d_ws, size_t ws_size, hipStream_t stream) {
    static int grid = 0;
    if (grid == 0) {
        if (n_in != 25 || in_sizes[0] != NLAT * D || out_size != NLAT * D || ws_size < WS_END) { fprintf(stderr, "kernel_launch: unexpected shapes (n_in %d, in0 %d, out %d, ws %zu < %zu); nothing launched\n", n_in, n_in > 0 ? in_sizes[0] : -1, out_size, ws_size, (size_t)WS_END); grid = -1; return; }
        int dev = 0, cus = 0, per_cu = 0;
        if (hipGetDevice(&dev) != hipSuccess || hipDeviceGetAttribute(&cus, hipDeviceAttributeMultiprocessorCount, dev) != hipSuccess) { grid = -1; return; }
        if (hipFuncSetAttribute((const void*)fwd_kernel, hipFuncAttributeMaxDynamicSharedMemorySize, LDS_BYTES) != hipSuccess) { fprintf(stderr, "kernel_launch: hipFuncSetAttribute failed\n"); grid = -1; return; }
        if (hipOccupancyMaxActiveBlocksPerMultiprocessor(&per_cu, (const void*)fwd_kernel, NWAVES * 64, LDS_BYTES) != hipSuccess || per_cu < 1) fprintf(stderr, "kernel_launch: note: occupancy query says %d\n", per_cu);
        (void)hipGetLastError();
        grid = cus;
    }
    if (grid < 0) return;
    if (hipMemsetAsync((char*)d_ws + WS_CTL, 0, CTL_ZERO_BYTES, stream) != hipSuccess) return;
    Args a{};
    for (int i = 0; i < 25; ++i) a.in[i] = (const float*)d_in[i];
    a.out = (float*)d_out; a.ws = (unsigned char*)d_ws;
#if MK_PER_STEP
    for (int s = 0; s < N_STEPS; ++s) { a.ph_lo = s; a.ph_hi = s + 1; hipLaunchKernelGGL(fwd_kernel, dim3(grid), dim3(NWAVES * 64), LDS_BYTES, stream, a); }
#else
    a.ph_lo = 0; a.ph_hi = N_STEPS;
    hipLaunchKernelGGL(fwd_kernel, dim3(grid), dim3(NWAVES * 64), LDS_BYTES, stream, a);
#endif
}
```

```cpp
#include <hip/hip_runtime.h>
#include <cstdio>
#include <cstdint>

namespace pg8 {
#define PG8_LAS __attribute__((address_space(3)))
typedef unsigned short bf16_t;
typedef short bf16x8 __attribute__((ext_vector_type(8)));
typedef float f32x4 __attribute__((ext_vector_type(4)));
typedef unsigned u32x4 __attribute__((ext_vector_type(4)));
typedef int v4i_t __attribute__((ext_vector_type(4)));
typedef int v8i_t __attribute__((ext_vector_type(8)));
constexpr int BM = 256, BK = 64, HALF = 128, HTB = HALF * BK * 2  , STAGE_BYTES = 8 * HTB, NXCD = 8, WGM = 8;

__host__ __device__ __forceinline__ int lds_byte(int r, int c) { const int st = (r >> 4) * 2 + (c >> 5), rr = r & 15, cc = c & 31, ob = rr * 64 + cc * 2; return st * 1024 + (ob ^ (((ob >> 9) & 1) << 5)); }
__host__ __device__ __forceinline__ void stage_rc(int b, int& R, int& C) { const int st = b / 1024, sb = b % 1024, swz = sb ^ (((sb >> 9) & 1) << 5); R = (st >> 1) * 16 + swz / 64; C = (st & 1) * 32 + (swz % 64) / 2; }
__host__ __device__ __forceinline__ int perm32(int rho) { const int n = rho >> 4, i = rho & 15; return 8 * (i >> 2) + 4 * n + (i & 3); }

constexpr int PRE_IDX_OFF = 139264, PRE_SG_OFF = PRE_IDX_OFF + 4096;
struct Unit { int pm, pn; };
struct Gemm { const bf16_t* A; const bf16_t* Bt; int lda, K; };

struct StaticOrder {
    int nM, nN, nwg, G, c;
    __host__ __device__ __forceinline__ void init(int M, int N, int G_, int c_) { nM = M / BM; nN = N / BM; nwg = nM * nN; G = G_; c = c_; }
    __host__ __device__ __forceinline__ bool next(int i, Unit& u) const {
        const int L = i * G + c; if (L >= nwg) return false;
        int wgid = L; { const int q = nwg / NXCD, r = nwg % NXCD, xcd = wgid % NXCD, off = wgid / NXCD; wgid = (xcd < r ? xcd * (q + 1) : r * (q + 1) + (xcd - r) * q) + off; }
        const int nig = WGM * nN, gid = wgid / nig, fm = gid * WGM, gsz = (nM - fm) < WGM ? (nM - fm) : WGM;
        u.pm = fm + ((wgid % nig) % gsz); u.pn = (wgid % nig) / gsz; return true;
    }
    static constexpr bool GATHER = false;
    __device__ __forceinline__ int arow(const Unit& u, int r) const { return u.pm * BM + r; }
    __device__ __forceinline__ bool routed(const Unit&) const { return false; }
    __device__ __forceinline__ const int* rowlist(const Unit&) const { return nullptr; }
};

typedef __bf16 bf16x2_t __attribute__((ext_vector_type(2)));
typedef float f32x2_t __attribute__((ext_vector_type(2)));
__device__ __forceinline__ unsigned cvt_pk_bf16(float lo, float hi) { const f32x2_t v = {lo, hi}; const bf16x2_t r = __builtin_convertvector(v, bf16x2_t); return __builtin_bit_cast(unsigned, r); }
__device__ __forceinline__ int cvt_pk_fp8_sat(float a, float b, int old, bool hi) {
    float lim; asm volatile("v_mov_b32 %0, 0x43e00000" : "=v"(lim));
    a = __builtin_amdgcn_fmed3f(a, -lim, lim); b = __builtin_amdgcn_fmed3f(b, -lim, lim);
    return hi ? __builtin_amdgcn_cvt_pk_fp8_f32(a, b, old, true) : __builtin_amdgcn_cvt_pk_fp8_f32(a, b, old, false);
}
__device__ __forceinline__ float bflo(unsigned w) { return __uint_as_float(w << 16); }
__device__ __forceinline__ float bfhi(unsigned w) { return __uint_as_float(w & 0xffff0000u); }
__device__ __forceinline__ float sigm(float x) { return 1.0f / (1.0f + __expf(-x)); }


__device__ __forceinline__ u32x4 swap_lane1(u32x4 v) { u32x4 r; r.x = (unsigned)__builtin_amdgcn_update_dpp(0, (int)v.x, 0xB1, 0xf, 0xf, false); r.y = (unsigned)__builtin_amdgcn_update_dpp(0, (int)v.y, 0xB1, 0xf, 0xf, false);
    r.z = (unsigned)__builtin_amdgcn_update_dpp(0, (int)v.z, 0xB1, 0xf, 0xf, false); r.w = (unsigned)__builtin_amdgcn_update_dpp(0, (int)v.w, 0xB1, 0xf, 0xf, false); return r; }
struct EpiBf16 {
    static constexpr bool PRE = false, PERM = true, MID = false, P16 = false, P32 = true;
    bf16_t* O; int ldc; float scale; unsigned char* G8; int gt0;
    __device__ __forceinline__ void operator()(const f32x4 (&acc)[2][2][4][2], const Unit& u, int wr, int wc, int fr, int fq) const {
        if (u.pn >= gt0) {
            const bool oq = fq & 1;
            const int row0 = u.pm * BM + wr * 64 + fr, col0 = (u.pn - gt0) * BM + wc * 64 + (oq ? 32 + 8 * (fq - 1) : 8 * fq);
            float k255 = 255.0f; asm volatile("" : "+v"(k255));
#pragma unroll
            for (int ai = 0; ai < 2; ++ai)
#pragma unroll
                for (int m = 0; m < 4; ++m) { unsigned d[2][2];
#pragma unroll
                    for (int bj = 0; bj < 2; ++bj)
#pragma unroll
                        for (int n = 0; n < 2; ++n) { unsigned w = 0;
#pragma unroll
                            for (int i = 0; i < 4; ++i) { const float sg = k255 * __builtin_amdgcn_rcpf(1.0f + __expf(-acc[ai][bj][m][n][i] * scale)); w = __builtin_amdgcn_cvt_pk_u8_f32(fmaxf(sg, 1.0f), i, w); }
                            d[bj][n] = w; }
                    const auto s0 = __builtin_amdgcn_permlane16_swap(d[0][0], d[1][0], false, false), s1 = __builtin_amdgcn_permlane16_swap(d[0][1], d[1][1], false, false);
                    u32x4 w; w.x = s0[0]; w.y = s1[0]; w.z = s0[1]; w.w = s1[1];
                    *(u32x4*)(G8 + (size_t)(row0 + ai * HALF + m * 16) * 3072 + col0) = w; }
            return; }
        const bool odd = fr & 1;
        const int row0 = u.pm * BM + wr * 64 + (fr & ~1), col0 = u.pn * BM + wc * 64 + 8 * fq + (odd ? 32 : 0);
#pragma unroll
        for (int ai = 0; ai < 2; ++ai)
#pragma unroll
            for (int m = 0; m < 4; ++m) { bf16_t* rowp = O + (size_t)(row0 + ai * HALF + m * 16) * ldc + col0;
                u32x4 w[2];
#pragma unroll
                for (int bj = 0; bj < 2; ++bj) { const f32x4 v0 = acc[ai][bj][m][0] * scale, v1 = acc[ai][bj][m][1] * scale;
                    w[bj].x = cvt_pk_bf16(v0[0], v0[1]); w[bj].y = cvt_pk_bf16(v0[2], v0[3]); w[bj].z = cvt_pk_bf16(v1[0], v1[1]); w[bj].w = cvt_pk_bf16(v1[2], v1[3]); }
                const u32x4 got = swap_lane1(odd ? w[0] : w[1]);
                *(u32x4*)rowp = odd ? got : w[0]; *(u32x4*)(rowp + ldc) = odd ? w[1] : got; }
    }
};
template <bool FIRST> struct EpiBranch {
    static constexpr bool PRE = false, PERM = true, MID = false, P16 = false, P32 = false;
    bf16_t* MG; const bf16_t* gate; int ldc, ldg; float scale;
    __device__ __forceinline__ void operator()(const f32x4 (&acc)[2][2][4][2], const Unit& u, int wr, int wc, int fr, int fq) const {
        const int row0 = u.pm * BM + wr * 64 + fr, col0 = u.pn * BM + wc * 32 + 8 * fq;
#pragma unroll
        for (int ai = 0; ai < 2; ++ai)
#pragma unroll
            for (int m = 0; m < 4; ++m) { const size_t r = (size_t)(row0 + ai * HALF + m * 16);
#pragma unroll
                for (int bj = 0; bj < 2; ++bj) { const f32x4 v0 = acc[ai][bj][m][0] * scale, v1 = acc[ai][bj][m][1] * scale;
                    const u32x4 gw = *(const u32x4*)(gate + r * ldg + col0 + bj * HALF);
                    float o[8];
                    o[0] = sigm(bflo(gw.x)) * v0[0]; o[1] = sigm(bfhi(gw.x)) * v0[1]; o[2] = sigm(bflo(gw.y)) * v0[2]; o[3] = sigm(bfhi(gw.y)) * v0[3];
                    o[4] = sigm(bflo(gw.z)) * v1[0]; o[5] = sigm(bfhi(gw.z)) * v1[1]; o[6] = sigm(bflo(gw.w)) * v1[2]; o[7] = sigm(bfhi(gw.w)) * v1[3];
                    bf16_t* dst = MG + r * ldc + col0 + bj * HALF;
                    if (!FIRST) { const u32x4 pw = *(const u32x4*)dst;
                        o[0] += bflo(pw.x); o[1] += bfhi(pw.x); o[2] += bflo(pw.y); o[3] += bfhi(pw.y); o[4] += bflo(pw.z); o[5] += bfhi(pw.z); o[6] += bflo(pw.w); o[7] += bfhi(pw.w); }
                    u32x4 w; w.x = cvt_pk_bf16(o[0], o[1]); w.y = cvt_pk_bf16(o[2], o[3]); w.z = cvt_pk_bf16(o[4], o[5]); w.w = cvt_pk_bf16(o[6], o[7]);
                    *(u32x4*)dst = w; } }
    }
};
struct EpiBranchCat {
    static constexpr bool PRE = false, PERM = true, MID = true, P16 = true, P32 = false;
    bf16_t* MG; const unsigned char* gate; int ldc, ldg; float scale;
    static __device__ __forceinline__ float ub(unsigned w, int i) { return (float)((w >> (8 * i)) & 0xffu); }
    __device__ __forceinline__ void mid(f32x4 (&acc)[2][2][4][2], const Unit& u, int seg, int wr, int wc, int fr, int fq) const {
        const int row0 = u.pm * BM + wr * 64 + fr, col0 = u.pn * BM + wc * 64 + 16 * fq;
#pragma unroll
        for (int ai = 0; ai < 2; ++ai) {
            u32x4 ga[4], gb[4];
#pragma unroll
            for (int m = 0; m < 4; ++m) { const unsigned char* gp = gate + (size_t)(row0 + ai * HALF + m * 16) * ldg + seg * 1024 + col0; ga[m] = *(const u32x4*)gp; gb[m] = *(const u32x4*)(gp + 1024); }
            __builtin_amdgcn_sched_barrier(0);
#pragma unroll
            for (int m = 0; m < 4; ++m) {
#pragma unroll
                for (int bj = 0; bj < 2; ++bj)
#pragma unroll
                    for (int n = 0; n < 2; ++n)
#pragma unroll
                        for (int i = 0; i < 4; ++i) acc[ai][bj][m][n][i] *= ub(ga[m][2 * bj + n], i) * __builtin_amdgcn_rcpf(ub(gb[m][2 * bj + n], i)); }
            __builtin_amdgcn_sched_barrier(0); }
    }
    __device__ __forceinline__ void operator()(const f32x4 (&acc)[2][2][4][2], const Unit& u, int wr, int wc, int fr, int fq) const {
        const int row0 = u.pm * BM + wr * 64 + fr, col0 = u.pn * BM + wc * 64 + 16 * fq;
        float sc = scale * (1.0f / 255.0f); asm volatile("" : "+v"(sc));
        u32x4 gws[2][4];
#pragma unroll
        for (int ai = 0; ai < 2; ++ai)
#pragma unroll
            for (int m = 0; m < 4; ++m) gws[ai][m] = *(const u32x4*)(gate + (size_t)(row0 + ai * HALF + m * 16) * ldg + 2048 + col0);
        __builtin_amdgcn_sched_barrier(0);
#pragma unroll
        for (int ai = 0; ai < 2; ++ai)
#pragma unroll
            for (int m = 0; m < 4; ++m) { const size_t r = (size_t)(row0 + ai * HALF + m * 16);
                const u32x4 gw = gws[ai][m];
                u32x4 o;
#pragma unroll
                for (int bj = 0; bj < 2; ++bj)
#pragma unroll
                    for (int n = 0; n < 2; ++n) { const f32x4 v = acc[ai][bj][m][n] * sc; const unsigned g = gw[2 * bj + n]; int w = 0;
                        w = cvt_pk_fp8_sat(ub(g, 0) * v[0], ub(g, 1) * v[1], w, false); w = cvt_pk_fp8_sat(ub(g, 2) * v[2], ub(g, 3) * v[3], w, true); o[2 * bj + n] = (unsigned)w; }
                *(u32x4*)((unsigned char*)MG + r * ldc + col0) = o; }
    }
};
template <bool SRC_F32> struct EpiResid {
    static constexpr bool PRE = false, PERM = true, MID = false, P16 = false, P32 = true;
    bf16_t* X; const float* srcl; const float* srcc; const float* gmod; int nlat; int gstride; float scale;
    __device__ __forceinline__ void operator()(const f32x4 (&acc)[2][2][4][2], const Unit& u, int wr, int wc, int fr, int fq) const {
        const int row0 = u.pm * BM + wr * 64 + fr, col0 = u.pn * BM + wc * 64 + 8 * fq;
        const int rt = u.pm * BM; const int bi = rt < nlat ? (rt >> 12) : 8;
        const float* sbase = rt < nlat ? srcl : (srcc - (size_t)nlat * 1024);
        f32x4 gv[2][2];
#pragma unroll
        for (int bj = 0; bj < 2; ++bj)
#pragma unroll
            for (int n = 0; n < 2; ++n) gv[bj][n] = *(const f32x4*)(gmod + (size_t)bi * gstride + col0 + bj * 32 + n * 4) * scale;
#pragma unroll
        for (int ai = 0; ai < 2; ++ai) {
            f32x4 sf[SRC_F32 ? 4 : 1][2][2]; u32x4 sw[SRC_F32 ? 1 : 4][2];
#pragma unroll
            for (int m = 0; m < 4; ++m) { const size_t off = (size_t)(row0 + ai * HALF + m * 16) * 1024 + col0;
#pragma unroll
                for (int bj = 0; bj < 2; ++bj) {
                    if constexpr (SRC_F32) { sf[m][bj][0] = *(const f32x4*)(sbase + off + bj * 32); sf[m][bj][1] = *(const f32x4*)(sbase + off + bj * 32 + 4); }
                    else sw[m][bj] = *(const u32x4*)(X + off + bj * 32); } }
            __builtin_amdgcn_sched_barrier(0);
#pragma unroll
            for (int m = 0; m < 4; ++m) { const size_t off = (size_t)(row0 + ai * HALF + m * 16) * 1024 + col0;
#pragma unroll
                for (int bj = 0; bj < 2; ++bj) { f32x4 s0, s1;
                    if constexpr (SRC_F32) { s0 = sf[m][bj][0]; s1 = sf[m][bj][1]; }
                    else { const u32x4 w = sw[m][bj]; s0 = (f32x4){bflo(w.x), bfhi(w.x), bflo(w.y), bfhi(w.y)}; s1 = (f32x4){bflo(w.z), bfhi(w.z), bflo(w.w), bfhi(w.w)}; }
                    const f32x4 o0 = s0 + gv[bj][0] * acc[ai][bj][m][0], o1 = s1 + gv[bj][1] * acc[ai][bj][m][1];
                    u32x4 w; w.x = cvt_pk_bf16(o0[0], o0[1]); w.y = cvt_pk_bf16(o0[2], o0[3]); w.z = cvt_pk_bf16(o1[0], o1[1]); w.w = cvt_pk_bf16(o1[2], o1[3]);
                    *(u32x4*)(X + off + bj * 32) = w; } }
            __builtin_amdgcn_sched_barrier(0); }
    }
};
struct EpiF32 {
    static constexpr bool PRE = false, PERM = false, MID = false, P16 = false, P32 = false;
    float* C; int ldc;
    __device__ __forceinline__ void operator()(const f32x4 (&acc)[2][2][4][2], const Unit& u, int wr, int wc, int fr, int fq) const {
        const int row0 = u.pm * BM + wr * 64 + fr, col0 = wc * 32 + 4 * fq;
#pragma unroll
        for (int ai = 0; ai < 2; ++ai)
#pragma unroll
            for (int m = 0; m < 4; ++m) { float* rowp = C + (size_t)(row0 + ai * HALF + m * 16) * ldc + col0;
#pragma unroll
                for (int bj = 0; bj < 2; ++bj)
#pragma unroll
                    for (int n = 0; n < 2; ++n) *(f32x4*)(rowp + bj * HALF + n * 16) = acc[ai][bj][m][n]; }
    }
};
struct EpiGateUp {
    static constexpr bool PRE = true, PERM = true, MID = false, P16 = false, P32 = false;
    bf16_t* HS; const float* SG; int nshrows; float scale; static constexpr int ncol = 2;
    __device__ __forceinline__ void pre(const Unit& u, int slot, PG8_LAS unsigned char* lds, int tid) const {
        const int w = __builtin_amdgcn_readfirstlane(tid >> 6);
        if (u.pm * BM >= nshrows && w >= 4) __builtin_amdgcn_global_load_lds((const unsigned*)(SG + u.pm * BM + (w - 4) * 64 + (tid & 63)), (PG8_LAS unsigned*)(lds + PRE_SG_OFF + slot * 1024 + (w - 4) * 256), 4, 0, 0);
    }
    __device__ __forceinline__ void operator()(const f32x4 (&acc)[2][2][4][2], const Unit& u, int wr, int wc, int fr, int fq, int slot, PG8_LAS unsigned char* lds) const {
        const int row0 = u.pm * BM + wr * 64 + fr, col0 = (u.pn % ncol) * HALF + wc * 32 + 8 * fq;
        const bool sh = u.pm * BM < nshrows;
        float sgv[2][4];
        const PG8_LAS float* sgl = (const PG8_LAS float*)(lds + PRE_SG_OFF + slot * 1024) + wr * 64 + fr;
#pragma unroll
        for (int ai = 0; ai < 2; ++ai)
#pragma unroll
            for (int m = 0; m < 4; ++m) sgv[ai][m] = sh ? 1.0f : sgl[ai * HALF + m * 16];
        const bool oq = fq & 1;
        unsigned char* base = (unsigned char*)HS + (size_t)(row0 + (oq ? 16 : 0)) * 256 + (col0 - (oq ? 8 : 0));
#pragma unroll
        for (int ai = 0; ai < 2; ++ai)
#pragma unroll
            for (int mp = 0; mp < 2; ++mp) { unsigned d[2][2];
#pragma unroll
                for (int mm = 0; mm < 2; ++mm) { const int m = 2 * mp + mm;
                    const float su = sgv[ai][m] * scale; const f32x4 g0 = acc[ai][0][m][0] * scale, g1 = acc[ai][0][m][1] * scale, u0 = acc[ai][1][m][0] * su, u1 = acc[ai][1][m][1] * su;
                    float o[8];
#pragma unroll
                    for (int j = 0; j < 4; ++j) { o[j] = g0[j] * sigm(g0[j]) * u0[j]; o[4 + j] = g1[j] * sigm(g1[j]) * u1[j]; }
                    int w0 = 0, w1 = 0; w0 = cvt_pk_fp8_sat(o[0] * 16.0f, o[1] * 16.0f, w0, false); w0 = cvt_pk_fp8_sat(o[2] * 16.0f, o[3] * 16.0f, w0, true);
                    w1 = cvt_pk_fp8_sat(o[4] * 16.0f, o[5] * 16.0f, w1, false); w1 = cvt_pk_fp8_sat(o[6] * 16.0f, o[7] * 16.0f, w1, true);
                    d[mm][0] = (unsigned)w0; d[mm][1] = (unsigned)w1; }
                const auto s0 = __builtin_amdgcn_permlane16_swap(d[0][0], d[1][0], false, false), s1 = __builtin_amdgcn_permlane16_swap(d[0][1], d[1][1], false, false);
                u32x4 w; w.x = s0[0]; w.y = s1[0]; w.z = s0[1]; w.w = s1[1];
                *(u32x4*)(base + (size_t)(ai * HALF + mp * 32) * 256) = w; }
    }
};
struct EpiDown {
    static constexpr bool PRE = false, PERM = true, MID = false, P16 = true, P32 = false;
    unsigned char* Y; static constexpr int ncol = 4;
    __device__ __forceinline__ void operator()(const f32x4 (&acc)[2][2][4][2], const Unit& u, int wr, int wc, int fr, int fq) const {
        const int row0 = u.pm * BM + wr * 64 + fr, col0 = (u.pn % ncol) * BM + wc * 64 + 16 * fq;
#pragma unroll
        for (int ai = 0; ai < 2; ++ai)
#pragma unroll
            for (int m = 0; m < 4; ++m) { const int r = row0 + ai * HALF + m * 16; u32x4 w;
#pragma unroll
                for (int q = 0; q < 4; ++q) { const f32x4 v = acc[ai][q >> 1][m][q & 1] * (1.0f / 64.0f);
                    int x = 0; x = cvt_pk_fp8_sat(v[0], v[1], x, false); x = cvt_pk_fp8_sat(v[2], v[3], x, true); w[q] = (unsigned)x; }
                *(u32x4*)(Y + (size_t)r * 1024 + col0) = w; }
    }
};

template <class Epi, class Sched, bool ALIGN_EPI = true, bool FP8 = false>
__device__ __forceinline__ void gemm_phase(PG8_LAS unsigned char* lds, const Gemm g, const Sched& S, const Epi& E, int tid_in) {
    int tid = tid_in; asm volatile("" : "+v"(tid));
    const int wid = __builtin_amdgcn_readfirstlane(tid >> 6), lane = tid & 63, wr = wid >> 2, wc = wid & 3, fr = lane & 15, fq = lane >> 4;
    int K = g.K; asm volatile("" : "+s"(K));
    const int nt = K / BK;
    constexpr bool GA = Sched::GATHER;
    unsigned voffA[2], voffB[2];
    const unsigned lda2 = (unsigned)g.lda * 2u;
#pragma unroll
    for (int i = 0; i < 2; ++i) { int R, C; stage_rc(tid * 16 + i * 8192, R, C);
        const int Rb = Epi::P16 ? ((R >> 5) * 64 + ((R & 15) >> 2) * 16 + ((R >> 4) & 1) * 4 + (R & 3)) : Epi::P32 ? ((R >> 5) * 64 + ((R & 15) >> 2) * 8 + ((R >> 4) & 1) * 4 + (R & 3)) : (Epi::PERM ? ((R & ~31) + perm32(R & 31)) : R);
        voffA[i] = (unsigned)R * lda2 + (unsigned)C * 2u; voffB[i] = (unsigned)(Rb * K + C) * 2u; }
    const size_t ahstep = (size_t)HALF * lda2, atstep = 2 * ahstep;
#define PG8_GOFF(u, h, i) ({ int R_, C_; stage_rc(tid * 16 + (i) * 8192, R_, C_); (unsigned)S.arow(u, (h) * HALF + R_) * lda2 + (unsigned)C_ * 2u; })
    const size_t kstep = (size_t)(BK * 2);
    const size_t hstep = (size_t)HALF * K * 2;
    const size_t h1step = Epi::P16 ? (size_t)16 * K : Epi::P32 ? (size_t)64 * K : hstep;
    const size_t tstep = 2 * hstep;
    const unsigned ldsw = (unsigned)wid * 1024u;
    const int aoff = lds_byte(wr * 64 + fr, fq * 8), boff = lds_byte(wc * 32 + fr, fq * 8);
#define PG8_SA(b, h) (((b) * 2 + (h)) * HTB)
#define PG8_SB(b, h) ((4 + (b) * 2 + (h)) * HTB)
#define PG8_STAGE(bufoff, gbase, voff) do { const char* gb_ = (const char*)(gbase); asm volatile("" : "+s"(gb_));   \
        _Pragma("unroll") for (int _i = 0; _i < 2; ++_i) { unsigned vo_ = (voff)[_i]; asm volatile("" : "+v"(vo_));   \
        __builtin_amdgcn_global_load_lds((const unsigned*)(gb_ + vo_), (PG8_LAS unsigned*)(lds + (bufoff) + ldsw + _i * 8192), 16, 0, 0); } } while (0)
#define PG8_STAGEB1(bufoff, gbase) PG8_STAGE(bufoff, (gbase) + h1step, voffB)
#define PG8_STAGEA(bufoff, base, o0, o1) do { const char* ab_ = (const char*)(base); asm volatile("" : "+s"(ab_)); \
        unsigned o0_ = (o0), o1_ = (o1); asm volatile("" : "+v"(o0_), "+v"(o1_)); \
        __builtin_amdgcn_global_load_lds((const unsigned*)(ab_ + o0_), (PG8_LAS unsigned*)(lds + (bufoff) + ldsw), 16, 0, 0); \
        __builtin_amdgcn_global_load_lds((const unsigned*)(ab_ + o1_), (PG8_LAS unsigned*)(lds + (bufoff) + ldsw + 8192), 16, 0, 0); } while (0)
#define PG8_SA_CUR(bufoff, h, kb) do { if constexpr (GA) { if ((h) == 0) PG8_STAGEA(bufoff, (const char*)g.A + (kb), c00, c01); else PG8_STAGEA(bufoff, (const char*)g.A + (kb), c10, c11); } \
        else PG8_STAGEA(bufoff, cA + (h) * ahstep + (kb), voffA[0], voffA[1]); } while (0)
#define PG8_CAT(x, y) __builtin_shufflevector(x, y, 0, 1, 2, 3, 4, 5, 6, 7)
#define PG8_LO(x) __builtin_bit_cast(bf16x8, __builtin_shufflevector(x, x, 0, 1, 2, 3))
#define PG8_HI(x) __builtin_bit_cast(bf16x8, __builtin_shufflevector(x, x, 4, 5, 6, 7))
#define PG8_LDA(dst, b, h) do { _Pragma("unroll") for (int m = 0; m < 4; ++m) dst[m] = PG8_CAT(*(const PG8_LAS v4i_t*)(lds + PG8_SA(b, h) + aoff + m * 2048), *(const PG8_LAS v4i_t*)(lds + PG8_SA(b, h) + aoff + m * 2048 + 1024)); } while (0)
#define PG8_LDB(dst, b, h) do { _Pragma("unroll") for (int n = 0; n < 2; ++n) dst[n] = PG8_CAT(*(const PG8_LAS v4i_t*)(lds + PG8_SB(b, h) + boff + n * 2048), *(const PG8_LAS v4i_t*)(lds + PG8_SB(b, h) + boff + n * 2048 + 1024)); } while (0)
#define PG8_MMA(ai, bj, At, Bt) do { __builtin_amdgcn_s_setprio(1); _Pragma("unroll") for (int m = 0; m < 4; ++m) _Pragma("unroll") for (int n = 0; n < 2; ++n) { \
        if constexpr (FP8) acc[ai][bj][m][n] = __builtin_amdgcn_mfma_scale_f32_16x16x128_f8f6f4(Bt[n], At[m], acc[ai][bj][m][n], 0, 0, 0, 0, 0, 0); \
        else { acc[ai][bj][m][n] = __builtin_amdgcn_mfma_f32_16x16x32_bf16(PG8_LO(Bt[n]), PG8_LO(At[m]), acc[ai][bj][m][n], 0, 0, 0); \
               acc[ai][bj][m][n] = __builtin_amdgcn_mfma_f32_16x16x32_bf16(PG8_HI(Bt[n]), PG8_HI(At[m]), acc[ai][bj][m][n], 0, 0, 0); } } __builtin_amdgcn_s_setprio(0); } while (0)
#define PG8_LDA2(dst, b, h, mb) do { _Pragma("unroll") for (int m = 0; m < 2; ++m) dst[m] = PG8_CAT(*(const PG8_LAS v4i_t*)(lds + PG8_SA(b, h) + aoff + ((mb) + m) * 2048), *(const PG8_LAS v4i_t*)(lds + PG8_SA(b, h) + aoff + ((mb) + m) * 2048 + 1024)); } while (0)
#define PG8_MMA2(ai, bj, At, Bt, mb) do { _Pragma("unroll") for (int m = 0; m < 2; ++m) _Pragma("unroll") for (int n = 0; n < 2; ++n) \
        acc[ai][bj][(mb) + m][n] = __builtin_amdgcn_mfma_scale_f32_16x16x128_f8f6f4(Bt[n], At[m], acc[ai][bj][(mb) + m][n], 0, 0, 0, 0, 0, 0); } while (0)
#define PG8_LDA1(dst, b, h, mi) do { dst = PG8_CAT(*(const PG8_LAS v4i_t*)(lds + PG8_SA(b, h) + aoff + (mi) * 2048), *(const PG8_LAS v4i_t*)(lds + PG8_SA(b, h) + aoff + (mi) * 2048 + 1024)); } while (0)
#define PG8_MMA1(ai, Af, mi) do { _Pragma("unroll") for (int n = 0; n < 2; ++n) { \
        acc[ai][0][mi][n] = __builtin_amdgcn_mfma_scale_f32_16x16x128_f8f6f4(B0[n], Af, acc[ai][0][mi][n], 0, 0, 0, 0, 0, 0); \
        acc[ai][1][mi][n] = __builtin_amdgcn_mfma_scale_f32_16x16x128_f8f6f4(B1[n], Af, acc[ai][1][mi][n], 0, 0, 0, 0, 0, 0); } } while (0)
#define PG8_SP8(ai, b, h, LOADS) do { LOADS; PG8_LDA1(At[2], b, h, 2); PG8_LDA1(At[3], b, h, 3); PG8_WAIT_V(8); __builtin_amdgcn_s_waitcnt(0xC07F)  ; PG8_BAR; __builtin_amdgcn_s_setprio(1); PG8_MMA1(ai, At[0], 0); PG8_MMA1(ai, At[1], 1); PG8_MMA1(ai, At[2], 2); PG8_MMA1(ai, At[3], 3); __builtin_amdgcn_s_setprio(0); PG8_BAR; PG8_SCHED; } while (0)
#define PG8_WAIT_V(n) asm volatile("s_waitcnt vmcnt(" #n ")" ::: "memory")
#define PG8_WAIT_L(n) asm volatile("s_waitcnt lgkmcnt(" #n ")" ::: "memory")
#define PG8_BAR __builtin_amdgcn_s_barrier()
#define PG8_SCHED __builtin_amdgcn_sched_barrier(0)
    Unit cur, nxt; int ui = 0;
    if (!S.next(0, cur)) return;
    f32x4 acc[2][2][4][2];
#pragma unroll
    for (int a = 0; a < 2; ++a)
#pragma unroll
        for (int b = 0; b < 2; ++b)
#pragma unroll
            for (int m = 0; m < 4; ++m)
#pragma unroll
                for (int n = 0; n < 2; ++n) acc[a][b][m][n] = (f32x4){0.f, 0.f, 0.f, 0.f};
    v8i_t At[4], B0[2], B1[2];
    unsigned c00 = 0, c01 = 0, c10 = 0, c11 = 0;
    if constexpr (GA) { c00 = PG8_GOFF(cur, 0, 0); c01 = PG8_GOFF(cur, 0, 1); c10 = PG8_GOFF(cur, 1, 0); c11 = PG8_GOFF(cur, 1, 1); }
    if constexpr (Epi::PRE) E.pre(cur, 0, lds, tid);
#define PG8_GOFF_L(u, slot, h, i) ({ int R_, C_; stage_rc(tid * 16 + (i) * 8192, R_, C_); const int r_ = S.routed(u) ? ((const PG8_LAS int*)(lds + PRE_IDX_OFF + (slot) * 1024))[(h) * HALF + R_] : u.pm * BM + (h) * HALF + R_; (unsigned)r_ * lda2 + (unsigned)C_ * 2u; })
    const char* cA = (const char*)g.A + (size_t)cur.pm * atstep;
    const char* cB = (const char*)g.Bt + (size_t)cur.pn * tstep;
    PG8_STAGE(PG8_SB(0, 0), cB, voffB); PG8_STAGEB1(PG8_SB(0, 1), cB); PG8_SA_CUR(PG8_SA(0, 0), 0, 0); PG8_SA_CUR(PG8_SA(0, 1), 1, 0);
    if (wr == 1) PG8_BAR;
    PG8_WAIT_V(2); PG8_BAR;
    PG8_STAGE(PG8_SB(1, 0), cB + kstep, voffB); PG8_SA_CUR(PG8_SA(1, 0), 0, kstep); PG8_STAGEB1(PG8_SB(1, 1), cB + kstep);
    PG8_WAIT_V(6); PG8_BAR;
    for (;;) {
        const bool has_next = S.next(ui + 1, nxt);
        const char* nB = has_next ? (const char*)g.Bt + (size_t)nxt.pn * tstep : cB;
        const char* nA = has_next ? (const char*)g.A + (size_t)nxt.pm * atstep : cA;
        if constexpr (GA) { if (has_next && S.routed(nxt) && wid < 4) __builtin_amdgcn_global_load_lds((const unsigned*)(S.rowlist(nxt) + wid * 64 + lane), (PG8_LAS unsigned*)(lds + PRE_IDX_OFF + ((ui + 1) & 3) * 1024 + wid * 256), 4, 0, 0); }
        if constexpr (Epi::PRE) { if (has_next) E.pre(nxt, (ui + 1) & 3, lds, tid); }
        for (int t = 0; t < nt; t += 2) {
            const bool last = (t == nt - 2);
            const size_t kb1 = (size_t)(t + 1) * kstep;
            const size_t kb2 = last ? (size_t)0 : (size_t)(t + 2) * kstep;
            const char* b2 = last ? nB : cB + (size_t)(t + 2) * kstep;
            size_t kb3 = kb2 + kstep; const char* b3 = b2 + kstep;
            asm volatile("" : "+s"(kb3), "+s"(b3));
            if constexpr (FP8) {
            PG8_SP8(0, 0, 0, PG8_LDB(B0, 0, 0); PG8_LDB(B1, 0, 1); PG8_SCHED; PG8_LDA2(At, 0, 0, 0); PG8_SA_CUR(PG8_SA(1, 1), 1, kb1));
            if (last) { cA = nA; if constexpr (GA) { if (has_next) { const int sl_ = (ui + 1) & 3; c00 = PG8_GOFF_L(nxt, sl_, 0, 0); c01 = PG8_GOFF_L(nxt, sl_, 0, 1); c10 = PG8_GOFF_L(nxt, sl_, 1, 0); c11 = PG8_GOFF_L(nxt, sl_, 1, 1); } } }
            PG8_SP8(1, 0, 1, PG8_LDA2(At, 0, 1, 0); PG8_STAGE(PG8_SB(0, 0), b2, voffB); PG8_STAGEB1(PG8_SB(0, 1), b2); PG8_SA_CUR(PG8_SA(0, 0), 0, kb2));
            PG8_SP8(0, 1, 0, PG8_LDB(B0, 1, 0); PG8_LDB(B1, 1, 1); PG8_SCHED; PG8_LDA2(At, 1, 0, 0); PG8_SA_CUR(PG8_SA(0, 1), 1, kb2));
            PG8_SP8(1, 1, 1, PG8_LDA2(At, 1, 1, 0); PG8_STAGE(PG8_SB(1, 0), b3, voffB); PG8_STAGEB1(PG8_SB(1, 1), b3); PG8_SA_CUR(PG8_SA(1, 0), 0, kb3));
            if constexpr (Epi::MID) { if (t == 0 || t == 4) { int fr_ = fr, fq_ = fq; asm volatile("" : "+v"(fr_), "+v"(fq_)); E.mid(acc, cur, t == 0 ? 0 : 1, wr, wc, fr_, fq_); } }
            } else {
            PG8_LDB(B0, 0, 0); PG8_LDB(B1, 0, 1); PG8_SCHED; PG8_LDA(At, 0, 0); PG8_SA_CUR(PG8_SA(1, 1), 1, kb1);
            PG8_WAIT_V(8); PG8_WAIT_L(0); PG8_BAR; PG8_MMA(0, 0, At, B0); PG8_MMA(0, 1, At, B1); PG8_BAR; PG8_SCHED;
            if (last) { cA = nA; if constexpr (GA) { if (has_next) { const int sl_ = (ui + 1) & 3; c00 = PG8_GOFF_L(nxt, sl_, 0, 0); c01 = PG8_GOFF_L(nxt, sl_, 0, 1); c10 = PG8_GOFF_L(nxt, sl_, 1, 0); c11 = PG8_GOFF_L(nxt, sl_, 1, 1); } } }
            PG8_LDA(At, 0, 1); PG8_STAGE(PG8_SB(0, 0), b2, voffB); PG8_STAGEB1(PG8_SB(0, 1), b2); PG8_SA_CUR(PG8_SA(0, 0), 0, kb2);
            PG8_WAIT_V(8); PG8_WAIT_L(0); PG8_BAR; PG8_MMA(1, 0, At, B0); PG8_MMA(1, 1, At, B1); PG8_BAR; PG8_SCHED;
            PG8_LDB(B0, 1, 0); PG8_LDB(B1, 1, 1); PG8_SCHED; PG8_LDA(At, 1, 0); PG8_SA_CUR(PG8_SA(0, 1), 1, kb2);
            PG8_WAIT_V(8); PG8_WAIT_L(0); PG8_BAR; PG8_MMA(0, 0, At, B0); PG8_MMA(0, 1, At, B1); PG8_BAR; PG8_SCHED;
            PG8_LDA(At, 1, 1); PG8_STAGE(PG8_SB(1, 0), b3, voffB); PG8_STAGEB1(PG8_SB(1, 1), b3); PG8_SA_CUR(PG8_SA(1, 0), 0, kb3);
            PG8_WAIT_V(8); PG8_WAIT_L(0); PG8_BAR; PG8_MMA(1, 0, At, B0); PG8_MMA(1, 1, At, B1); PG8_BAR; PG8_SCHED;
        }
            }
        if constexpr (ALIGN_EPI) { if (wr == 0) PG8_BAR; }
        { int fr_ = fr, fq_ = fq; asm volatile("" : "+v"(fr_), "+v"(fq_)); if constexpr (Epi::PRE) E(acc, cur, wr, wc, fr_, fq_, ui & 3, lds); else E(acc, cur, wr, wc, fr_, fq_); }
        if (!has_next) break;
#pragma unroll
        for (int a = 0; a < 2; ++a)
#pragma unroll
            for (int b = 0; b < 2; ++b)
#pragma unroll
                for (int m = 0; m < 4; ++m)
#pragma unroll
                    for (int n = 0; n < 2; ++n) acc[a][b][m][n] = (f32x4){0.f, 0.f, 0.f, 0.f};
        cur = nxt; cB = nB; ++ui;
        if constexpr (ALIGN_EPI) { if (wr == 1) PG8_BAR; }
    }
    PG8_WAIT_V(0);
    if constexpr (!ALIGN_EPI) { if (wr == 0) PG8_BAR; }
    PG8_BAR;
#undef PG8_SA
#undef PG8_SB
#undef PG8_STAGE
#undef PG8_STAGEA
#undef PG8_STAGEB1
#undef PG8_SA_CUR
#undef PG8_GOFF
#undef PG8_GOFF_L
#undef PG8_LDA
#undef PG8_LDB
#undef PG8_MMA
#undef PG8_LDA2
#undef PG8_LDA1
#undef PG8_MMA1
#undef PG8_MMA2
#undef PG8_SP8
#undef PG8_CAT
#undef PG8_LO
#undef PG8_HI
#undef PG8_WAIT_V
#undef PG8_WAIT_L
#undef PG8_BAR
#undef PG8_SCHED
}
}

constexpr int NWAVES = 8;
constexpr int D = 1024, BATCH = 8, SEQ = 4096, NLAT = BATCH * SEQ, CTXL = 256, NCTX = BATCH * CTXL, T = NLAT + NCTX;
constexpr int DEPTH = 2, INC = 6144, NE = 256, TOPK = 8;
constexpr int C_FN = 0, C_Q = 256, C_K = 768, C_V = 1280, C_HQ = 1792, C_HI = 2048, C_HF = 2304, C_HB = 2560, C_HG = 2816, C_BG = 3072;
constexpr int M_SH1 = 0, M_SC1 = 1024, M_G1 = 2048, M_SH2 = 3072, M_SC2 = 4096, M_G2 = 5120;
constexpr int NSHT = T / 256;
constexpr int MAXRT = (NLAT + NCTX) * TOPK / 256 + NE;
constexpr int NCHUNK = 68;
constexpr float RMS_EPS = 1e-6f;
constexpr float LOG2E = 1.4426950408889634f;

constexpr size_t MiB = 1u << 20;
constexpr size_t WS_CTL = 0, CTL_ZERO_BYTES = 256 * 1024;
constexpr size_t WS_MOD = 2 * MiB;
constexpr size_t WS_CS64 = 2 * MiB + 512 * 1024;
constexpr size_t WS_TW = 2 * MiB + 576 * 1024;
constexpr size_t WS_CS256 = 3 * MiB;
constexpr size_t WS_W = 4 * MiB, W_LSTRIDE = 404 * MiB;
constexpr size_t W_IN = 0, W_FN = 12 * MiB, W_NA = 12 * MiB + 512 * 1024, W_HG = 13 * MiB + 512 * 1024, W_OUT = 14 * MiB, W_R = 16 * MiB, W_GU = 17 * MiB, W_D = 274 * MiB;
constexpr size_t WS_H = 812 * MiB;
constexpr size_t WS_X = 880 * MiB;
constexpr size_t WS_HS = 1016 * MiB;
constexpr size_t WS_SC = 1201 * MiB;
constexpr size_t WS_TKE = 1235 * MiB, WS_TKP = WS_TKE + 1088 * 1024, WS_TKG = WS_TKP + 1088 * 1024, WS_TSL = WS_TKG + 1088 * 1024;
constexpr size_t WS_STOK = 1240 * MiB;
constexpr size_t WS_SG = 1241 * MiB + 512 * 1024;
constexpr size_t WS_Y = 1243 * MiB;
constexpr size_t WS_Z = WS_Y, WS_MIX = WS_Y + 408 * MiB, WS_MG = WS_Y + 476 * MiB, WS_HL = WS_Y + 544 * MiB, WS_HSP = WS_Y + 612 * MiB, WS_HDEC = WS_Y + 646 * MiB,
                 WS_VTL = WS_Y + 648 * MiB, WS_VTC = WS_Y + 680 * MiB, WS_T1R = WS_Y + 682 * MiB, WS_T1I = WS_Y + 698 * MiB, WS_CP = WS_Y + 714 * MiB;
constexpr size_t WS_G8 = WS_HS;
constexpr size_t WS_H8 = 1983 * MiB;
constexpr size_t WS_END = 2017 * MiB;
constexpr float W8_SCALE = 64.0f;
static_assert(WS_CP + 4 * MiB <= WS_Y + 740 * MiB && WS_Y + 740 * MiB <= WS_END, "ws map");
constexpr int CW_TMO = 0, CW_TRQ = 64, CW_BAR = 4096, CW_CNT = 16384;

constexpr int RING_BYTES = 131072;
constexpr int LDSCTL_OFF = RING_BYTES, MISC_OFF = LDSCTL_OFF + 320, TE_OFF = MISC_OFF + 192, LDS_BYTES = 147456;
static_assert(TE_OFF + 2 * (MAXRT + 8) + 16 <= LDS_BYTES, "LDS map");

#define GAS __attribute__((address_space(1)))
#define LAS __attribute__((address_space(3)))
#define DI __device__ __forceinline__
typedef unsigned short bf16;
typedef unsigned v4u __attribute__((ext_vector_type(4)));
typedef unsigned v2u __attribute__((ext_vector_type(2)));
typedef float f32x4 __attribute__((ext_vector_type(4)));
typedef short bf16x8 __attribute__((ext_vector_type(8)));
typedef GAS unsigned gu32;
#define RLX_AGENT __ATOMIC_RELAXED, __HIP_MEMORY_SCOPE_AGENT
#define VM_WAIT() asm volatile("s_waitcnt vmcnt(0)" ::: "memory")
DI float bf2f(unsigned v) { return __uint_as_float(v << 16); }
DI float bflo(unsigned w) { return __uint_as_float(w << 16); }
DI float bfhi(unsigned w) { return __uint_as_float(w & 0xffff0000u); }
DI unsigned pk2(float lo, float hi) { return pg8::cvt_pk_bf16(lo, hi); }
DI unsigned f2bf(float f) { return pk2(f, 0.f) & 0xffffu; }
DI unsigned pk4_fp8w(float a, float b, float c, float d) { int w = 0; w = __builtin_amdgcn_cvt_pk_fp8_f32(a, b, w, false); w = __builtin_amdgcn_cvt_pk_fp8_f32(c, d, w, true); return (unsigned)w; }
DI unsigned pk4_fp8(float a, float b, float c, float d) { int w = 0; w = pg8::cvt_pk_fp8_sat(a, b, w, false); w = pg8::cvt_pk_fp8_sat(c, d, w, true); return (unsigned)w; }
DI float sigm(float x) { return 1.0f / (1.0f + __expf(-x)); }
DI float shx(float v, int o, int lane) { return __builtin_bit_cast(float, __builtin_amdgcn_ds_bpermute((lane ^ o) << 2, __builtin_bit_cast(int, v))); }
DI float wave_sum(float v, int lane) {
#pragma unroll
    for (int o = 1; o < 64; o <<= 1) v += shx(v, o, lane);
    return v;
}
DI f32x4 mfma16(bf16x8 a, bf16x8 b, f32x4 c) { return __builtin_amdgcn_mfma_f32_16x16x32_bf16(a, b, c, 0, 0, 0); }
DI bf16x8 ldfrag(const LAS bf16* img, int pitch, int r0, int k0, int lane) { return *(const LAS bf16x8*)(img + (r0 + (lane & 15)) * pitch + k0 + 8 * (lane >> 4)); }

#define XB_TMO      128
#define XB_XCNT(j)  (256  + 64 * (j))
#define XB_XSUB(j)  (1280 + 64 * (j))
#define XB_XGEN(j)  (2304 + 64 * (j))
#define XB_TOP      3328
#define XB_TOPGEN   3392
#define XCD_BAR_WORDS 3456
#define XB_SPIN_CAP (1u << 18)

__device__ __forceinline__ unsigned xb_ld(unsigned* p)              { return __hip_atomic_load(p, __ATOMIC_RELAXED, __HIP_MEMORY_SCOPE_AGENT); }
__device__ __forceinline__ unsigned xb_add(unsigned* p, unsigned v) { return __hip_atomic_fetch_add(p, v, __ATOMIC_RELAXED, __HIP_MEMORY_SCOPE_AGENT); }
__device__ __forceinline__ unsigned xb_xcc_id() { return (unsigned)__builtin_amdgcn_s_getreg((3 << 11) | 20) & 0xFu; }
#define XB_SPIN(cond, bar) do { unsigned _sp = 0; while (cond) { __builtin_amdgcn_s_sleep(1); \
    if ((++_sp & 255u) == 0u) { if (xb_ld(&(bar)[XB_TMO])) break; if (_sp > XB_SPIN_CAP) { atomicAdd(&(bar)[XB_TMO], 1u); break; } } } } while (0)

struct XcdBarrier {
    unsigned* bar; unsigned x;
    volatile LAS unsigned* st;
};

__device__ __forceinline__ XcdBarrier xcd_barrier_post(unsigned* bar, volatile LAS unsigned* st, bool t0) {
    XcdBarrier b; b.bar = bar; b.x = xb_xcc_id(); b.st = st;
    if (t0) (void)xb_add(&bar[XB_XCNT(b.x)], 1u);
    return b;
}
__device__ __forceinline__ void xcd_barrier_complete(unsigned* bar, unsigned x, unsigned& nloc, unsigned& nx) {
    const unsigned G = gridDim.x * gridDim.y * gridDim.z;
    unsigned sum, cnt, mine, sp = 0u;
    for (;;) {
        sum = 0u; cnt = 0u; mine = 0u;
#pragma unroll
        for (unsigned j = 0; j < 16; ++j) { const unsigned c = xb_ld(&bar[XB_XCNT(j)]); sum += c; cnt += (c > 0u) ? 1u : 0u; mine = (j == x) ? c : mine; }
        if (sum == G) break;
        __builtin_amdgcn_s_sleep(1);
        if ((++sp & 255u) == 0u) { if (xb_ld(&bar[XB_TMO])) break; if (sp > XB_SPIN_CAP) { atomicAdd(&bar[XB_TMO], 1u); break; } }
    }
    nloc = mine > 0u ? mine : 1u; nx = cnt > 0u ? cnt : 1u;
}

__device__ __forceinline__ void xcd_barrier(const XcdBarrier& b, bool t0) {
    asm volatile("s_waitcnt vmcnt(0)" ::: "memory");
    __syncthreads();
    if (t0) {
        unsigned* bar = b.bar;
        __builtin_amdgcn_s_waitcnt(0);
        unsigned nloc = b.st[0], nx = b.st[1];
        if (nloc == 0u) { xcd_barrier_complete(bar, b.x, nloc, nx); b.st[0] = nloc; b.st[1] = nx; }
        const unsigned old = xb_add(&bar[XB_XSUB(b.x)], 1u);
        const unsigned gen = old / nloc;
        if (old + 1u == (gen + 1u) * nloc) {
            __builtin_amdgcn_fence(__ATOMIC_RELEASE, "agent");
            asm volatile("s_waitcnt vmcnt(0)" ::: "memory");
            const unsigned og = xb_add(&bar[XB_TOP], 1u);
            const unsigned tg = og / nx;
            if (og + 1u == (tg + 1u) * nx) xb_add(&bar[XB_TOPGEN], 1u);
            else XB_SPIN(xb_ld(&bar[XB_TOPGEN]) == tg, bar);
            __builtin_amdgcn_fence(__ATOMIC_ACQUIRE, "agent");
            xb_add(&bar[XB_XGEN(b.x)], 1u);
            asm volatile("s_waitcnt vmcnt(0)" ::: "memory");
        } else {
            XB_SPIN(xb_ld(&bar[XB_XGEN(b.x)]) == gen, bar);
            __builtin_amdgcn_fence(__ATOMIC_ACQUIRE, "agent");
            asm volatile("s_waitcnt vmcnt(0)" ::: "memory");
        }
    }
    __syncthreads();
}


struct Args { const float* in[25]; float* out; unsigned char* ws; int ph_lo, ph_hi; };
struct Ctx {
    const float* in[25]; size_t z; float* out; unsigned char* ws; LAS unsigned char* lds;
    int tid, lane, wave, bid, G;
};
enum { I_X = 0, I_C, I_CTX, I_CCTX, I_WADA, I_BADA, I_N1G, I_N2G, I_WIN, I_RPB, I_HGLB, I_HGNG, I_WFN, I_WNA, I_WHG, I_WOUT, I_WR, I_BR, I_WEG, I_WEU, I_WED, I_WSG, I_WSU, I_WSD, I_FG };
DI const float* inp(const Ctx& C, int k) { return C.in[k] + C.z; }
DI bf16* wsb(const Ctx& C, size_t off) { return (bf16*)(C.ws + off); }
DI float* wsf(const Ctx& C, size_t off) { return (float*)(C.ws + off); }
DI int* wsi(const Ctx& C, size_t off) { return (int*)(C.ws + off); }
DI bf16* wl(const Ctx& C, int l, size_t off) { return (bf16*)(C.ws + WS_W + (size_t)l * W_LSTRIDE + off); }
DI const float* modp(const Ctx& C, int l, int bi, int off) { return (const float*)(C.ws + WS_MOD) + ((size_t)(l * 9 + bi)) * 6144 + off; }

DI void tr_item(const float* W, int N, int k0, int n0, bf16* WT, size_t drow0, int Kd, int lane) {
    float v[32];
#pragma unroll
    for (int i = 0; i < 32; ++i) v[i] = W[(size_t)(k0 + i) * N + n0 + lane];
    bf16* o = WT + (drow0 + lane) * (size_t)Kd + k0;
#pragma unroll
    for (int c = 0; c < 4; ++c) { v4u w; w.x = pk2(v[8 * c], v[8 * c + 1]); w.y = pk2(v[8 * c + 2], v[8 * c + 3]); w.z = pk2(v[8 * c + 4], v[8 * c + 5]); w.w = pk2(v[8 * c + 6], v[8 * c + 7]);
        *(v4u*)(o + 8 * c) = w; }
}
DI void tr_item8(const float* W, int N, int k0, int n0, unsigned char* WT8, size_t drow0, int Kd, int lane) {
    float v[32];
#pragma unroll
    for (int i = 0; i < 32; ++i) v[i] = W[(size_t)(k0 + i) * N + n0 + lane] * W8_SCALE;
    unsigned char* o = WT8 + (drow0 + lane) * (size_t)Kd + k0;
#pragma unroll
    for (int c = 0; c < 2; ++c) { v4u w; w.x = pk4_fp8(v[16 * c], v[16 * c + 1], v[16 * c + 2], v[16 * c + 3]); w.y = pk4_fp8(v[16 * c + 4], v[16 * c + 5], v[16 * c + 6], v[16 * c + 7]);
        w.z = pk4_fp8(v[16 * c + 8], v[16 * c + 9], v[16 * c + 10], v[16 * c + 11]); w.w = pk4_fp8(v[16 * c + 12], v[16 * c + 13], v[16 * c + 14], v[16 * c + 15]); *(v4u*)(o + 16 * c) = w; }
}
constexpr int TR_PER_LAYER = 2112 + 49344;
struct TrItem { const float* src; unsigned char* dst; int N; bool f8; int pitch; };
DI TrItem tr_decode(const Ctx& C, int it) {
    const int l = it / TR_PER_LAYER; int r = it - l * TR_PER_LAYER;
    const float* W; int N, kb, nb, Kd, koff = 0; size_t woff, drow0; bool f8 = false;
    if (r < 1536) { f8 = true; W = inp(C, I_WIN) + (size_t)l * 1024 * 6144; N = 6144; nb = r >> 4; kb = r & 15; woff = W_IN; drow0 = (size_t)nb * 64; Kd = 1024; }
    else if ((r -= 1536) < 64) { f8 = true; W = inp(C, I_WFN) + (size_t)l * 256 * 1024; N = 1024; nb = r >> 2; kb = r & 3; woff = W_FN; drow0 = (size_t)nb * 64; Kd = 1024; koff = 0; }
    else if ((r -= 64) < 128) { f8 = true; W = inp(C, I_WNA) + (size_t)l * 512 * 1024; N = 1024; nb = r >> 3; kb = r & 7; woff = W_FN; drow0 = (size_t)nb * 64; Kd = 1024; koff = 256; }
    else if ((r -= 128) < 64) { f8 = true; W = inp(C, I_WHG) + (size_t)l * 256 * 1024; N = 1024; nb = r >> 2; kb = r & 3; woff = W_FN; drow0 = (size_t)nb * 64; Kd = 1024; koff = 768; }
    else if ((r -= 64) < 256) { f8 = true; W = inp(C, I_WOUT) + (size_t)l * 1024 * 1024; N = 1024; nb = r >> 4; kb = r & 15; woff = W_OUT; drow0 = (size_t)nb * 64; Kd = 1024; }
    else if ((r -= 256) < 64) { W = inp(C, I_WR) + (size_t)l * 1024 * 256; N = 256; nb = r >> 4; kb = r & 15; woff = W_R; drow0 = (size_t)nb * 64; Kd = 1024; }
    else if ((r -= 64) < 16384) { f8 = true; const int e = r >> 6, q2 = r & 63; W = inp(C, I_WEG) + ((size_t)(l * 256 + e)) * 1024 * 256; N = 256; nb = q2 >> 4; kb = q2 & 15; woff = W_GU; drow0 = (size_t)e * 512 + (nb >> 1) * 256 + (nb & 1) * 64; Kd = 1024; }
    else if ((r -= 16384) < 16384) { f8 = true; const int e = r >> 6, q2 = r & 63; W = inp(C, I_WEU) + ((size_t)(l * 256 + e)) * 1024 * 256; N = 256; nb = q2 >> 4; kb = q2 & 15; woff = W_GU; drow0 = (size_t)e * 512 + (nb >> 1) * 256 + 128 + (nb & 1) * 64; Kd = 1024; }
    else if ((r -= 16384) < 16384) { f8 = true; const int e = r >> 6, q2 = r & 63; W = inp(C, I_WED) + ((size_t)(l * 256 + e)) * 256 * 1024; N = 1024; nb = q2 >> 2; kb = q2 & 3; woff = W_D; drow0 = (size_t)e * 1024 + nb * 64; Kd = 256; }
    else if ((r -= 16384) < 64) { f8 = true; W = inp(C, I_WSG) + (size_t)l * 1024 * 256; N = 256; nb = r >> 4; kb = r & 15; woff = W_GU; drow0 = (size_t)NE * 512 + (nb >> 1) * 256 + (nb & 1) * 64; Kd = 1024; }
    else if ((r -= 64) < 64) { f8 = true; W = inp(C, I_WSU) + (size_t)l * 1024 * 256; N = 256; nb = r >> 4; kb = r & 15; woff = W_GU; drow0 = (size_t)NE * 512 + (nb >> 1) * 256 + 128 + (nb & 1) * 64; Kd = 1024; }
    else { f8 = true; r -= 64; W = inp(C, I_WSD) + (size_t)l * 256 * 1024; N = 1024; nb = r >> 2; kb = r & 3; woff = W_D; drow0 = (size_t)NE * 1024 + nb * 64; Kd = 256; }
    TrItem t; t.src = W + (size_t)(kb * 64) * N + nb * 64 + C.lane; t.N = N; t.f8 = f8; t.pitch = Kd * (f8 ? 1 : 2);
    t.dst = (unsigned char*)wl(C, l, woff) + ((drow0 + C.lane) * (size_t)Kd + koff + kb * 64) * (f8 ? 1 : 2);
    return t;
}
DI void tr_load(const TrItem& t, float (&v)[64]) {
#pragma unroll
    for (int i = 0; i < 64; ++i) v[i] = __builtin_nontemporal_load(t.src + (size_t)i * t.N);
}
DI void tr_store(const TrItem& t, const float (&v)[64]) {
    if (t.f8) {
#pragma unroll
        for (int c = 0; c < 4; ++c) { v4u w; w.x = pk4_fp8w(v[16 * c] * W8_SCALE, v[16 * c + 1] * W8_SCALE, v[16 * c + 2] * W8_SCALE, v[16 * c + 3] * W8_SCALE); w.y = pk4_fp8w(v[16 * c + 4] * W8_SCALE, v[16 * c + 5] * W8_SCALE, v[16 * c + 6] * W8_SCALE, v[16 * c + 7] * W8_SCALE);
            w.z = pk4_fp8w(v[16 * c + 8] * W8_SCALE, v[16 * c + 9] * W8_SCALE, v[16 * c + 10] * W8_SCALE, v[16 * c + 11] * W8_SCALE); w.w = pk4_fp8w(v[16 * c + 12] * W8_SCALE, v[16 * c + 13] * W8_SCALE, v[16 * c + 14] * W8_SCALE, v[16 * c + 15] * W8_SCALE); *(v4u*)(t.dst + 16 * c) = w; }
    } else {
#pragma unroll
        for (int c = 0; c < 8; ++c) { v4u w; w.x = pk2(v[8 * c], v[8 * c + 1]); w.y = pk2(v[8 * c + 2], v[8 * c + 3]); w.z = pk2(v[8 * c + 4], v[8 * c + 5]); w.w = pk2(v[8 * c + 6], v[8 * c + 7]); *(v4u*)(t.dst + 16 * c) = w; }
    }
}
DI void tr_cvt_lds(const float (&v)[64], LAS unsigned char* wr) {
#pragma unroll
    for (int c = 0; c < 4; ++c) { v4u o; o.x = pk4_fp8w(v[16 * c] * W8_SCALE, v[16 * c + 1] * W8_SCALE, v[16 * c + 2] * W8_SCALE, v[16 * c + 3] * W8_SCALE); o.y = pk4_fp8w(v[16 * c + 4] * W8_SCALE, v[16 * c + 5] * W8_SCALE, v[16 * c + 6] * W8_SCALE, v[16 * c + 7] * W8_SCALE);
        o.z = pk4_fp8w(v[16 * c + 8] * W8_SCALE, v[16 * c + 9] * W8_SCALE, v[16 * c + 10] * W8_SCALE, v[16 * c + 11] * W8_SCALE); o.w = pk4_fp8w(v[16 * c + 12] * W8_SCALE, v[16 * c + 13] * W8_SCALE, v[16 * c + 14] * W8_SCALE, v[16 * c + 15] * W8_SCALE);
        *(LAS v4u*)(wr + 16 * c) = o; }
}
DI void tr_flush_pair(const Ctx& C, unsigned char* dst, int pitch) {
    LAS unsigned char* L = C.lds + C.wave * 9216; const int rr = C.lane >> 3, pc = C.lane & 7;
    unsigned char* d0 = dst + (ptrdiff_t)(rr - C.lane) * pitch + pc * 16;
#pragma unroll
    for (int j = 0; j < 8; ++j) { const v4u x = *(const LAS v4u*)(L + (8 * j + rr) * 144 + pc * 16); *(v4u*)(d0 + (ptrdiff_t)(8 * j) * pitch) = x; }
}
DI void p0_transposes(const Ctx& C) {
    unsigned* q = (unsigned*)(C.ws + WS_CTL) + CW_TRQ;
    LAS unsigned char* wr = C.lds + C.wave * 9216 + C.lane * 144;
    for (;;) {
        int base = 0; if (C.lane == 0) base = (int)__hip_atomic_fetch_add(q, 16u, RLX_AGENT);
        base = __builtin_amdgcn_readfirstlane(base);
        if (base >= DEPTH * TR_PER_LAYER) break;
        float va[64], vb[64];
        TrItem ta = tr_decode(C, base); tr_load(ta, va);
        if (ta.f8) {
            { const TrItem tb = tr_decode(C, base + 1); tr_load(tb, vb); }
            unsigned char* d = ta.dst; const int pitch = ta.pitch;
#pragma unroll 1
            for (int j = 0; j < 16; j += 2) {
                tr_cvt_lds(va, wr); if (j + 2 < 16) { ta = tr_decode(C, base + j + 2); tr_load(ta, va); }
                tr_cvt_lds(vb, wr + 64); if (j + 2 < 16) { const TrItem tb = tr_decode(C, base + j + 3); tr_load(tb, vb); }
                tr_flush_pair(C, d, pitch);
                d = ta.dst;
            }
        } else {
            TrItem tb;
            for (int j = 0; j < 16; j += 2) {
                tb = tr_decode(C, base + j + 1); tr_load(tb, vb);
                tr_store(ta, va);
                if (j + 2 < 16) { ta = tr_decode(C, base + j + 2); tr_load(ta, va); }
                tr_store(tb, vb);
            }
        }
    }
}
DI void p0_mod(const Ctx& C) {
    LAS float* sil = (LAS float*)C.lds; LAS float* red = sil + 9 * 1024;
    for (int i = C.tid; i < 9 * 1024; i += 512) { const int bi = i >> 10, k = i & 1023; const float c = bi < 8 ? inp(C, I_C)[bi * 1024 + k] : inp(C, I_CCTX)[k]; sil[i] = c * sigm(c); }
    __syncthreads();
    const int j = C.bid * 64 + C.lane, l = j / 6144, col = j - l * 6144, k0 = C.wave * 128;
    float acc[9];
#pragma unroll
    for (int bi = 0; bi < 9; ++bi) acc[bi] = 0.f;
    const float* w = inp(C, I_WADA) + (size_t)l * 1024 * 6144 + col;
#pragma unroll 16
    for (int k = k0; k < k0 + 128; ++k) { const float wv = w[(size_t)k * 6144];
#pragma unroll
        for (int bi = 0; bi < 9; ++bi) acc[bi] += sil[bi * 1024 + k] * wv; }
#pragma unroll
    for (int bi = 0; bi < 9; ++bi) red[(C.wave * 9 + bi) * 64 + C.lane] = acc[bi];
    __syncthreads();
    if (C.wave == 0) { float* mo = wsf(C, WS_MOD); const float b0 = inp(C, I_BADA)[l * 6144 + col];
#pragma unroll
        for (int bi = 0; bi < 9; ++bi) { float s = b0;
#pragma unroll
            for (int wv = 0; wv < 8; ++wv) s += red[(wv * 9 + bi) * 64 + C.lane];
            mo[(size_t)(l * 9 + bi) * 6144 + col] = s; } }
    __syncthreads();
}
DI void p0_tables(const Ctx& C) {
    bf16* cs = wsb(C, WS_CS64); float* tw = wsf(C, WS_TW);
    for (int i = C.tid; i < 8192; i += 512) { const int r = i >> 7, j = i & 127, jj = j & 63; float s, c; sincospif((float)((r * jj) & 63) * (1.0f / 32.0f), &s, &c); cs[i] = (bf16)f2bf(j < 64 ? c : s); }
    for (int i = C.tid; i < 4096; i += 512) { const int k1 = i >> 6, n2 = i & 63; float s, c; sincospif((float)(k1 * n2) * (1.0f / 2048.0f), &s, &c); tw[2 * i] = c; tw[2 * i + 1] = s; }
    bf16* c2 = wsb(C, WS_CS256);
    for (int i = C.tid; i < 256 * 256; i += 512) { const int k = i >> 8, n = i & 255; float s, c; sincospif((float)((k * n) & 255) * (1.0f / 128.0f), &s, &c); c2[k * 512 + n] = (bf16)f2bf(c); c2[k * 512 + 256 + n] = (bf16)f2bf(s); }
}
struct NRow { f32x4 x[4], sc[4], sh[4]; };
template <bool SRC_F32> DI void nrow_issue(const Ctx& C, const void* xl, const void* xc, int l, int m_sh, int m_sc, int row, NRow& R) {
    const int bi = row < NLAT ? (row >> 12) : 8;
    const float* sh = modp(C, l, bi, m_sh); const float* sc = modp(C, l, bi, m_sc);
#pragma unroll
    for (int j = 0; j < 2; ++j) { const int col = 8 * C.lane + 512 * j;
        if (SRC_F32) { const float* xr = row < NLAT ? (const float*)xl + (size_t)row * D : (const float*)xc + (size_t)(row - NLAT) * D; R.x[2 * j] = *(const f32x4*)(xr + col); R.x[2 * j + 1] = *(const f32x4*)(xr + col + 4); }
        else { const bf16* xr = (const bf16*)xl + (size_t)row * D; const v4u w = *(const v4u*)(xr + col); R.x[2 * j] = (f32x4){bflo(w.x), bfhi(w.x), bflo(w.y), bfhi(w.y)}; R.x[2 * j + 1] = (f32x4){bflo(w.z), bfhi(w.z), bflo(w.w), bfhi(w.w)}; }
        R.sc[2 * j] = *(const f32x4*)(sc + col); R.sc[2 * j + 1] = *(const f32x4*)(sc + col + 4); R.sh[2 * j] = *(const f32x4*)(sh + col); R.sh[2 * j + 1] = *(const f32x4*)(sh + col + 4); }
}
template <bool SRC_F32> DI void norm_mod_rows(const Ctx& C, const void* xl, const void* xc, const float* gain, int l, int m_sh, int m_sc, bf16* H, unsigned char* H8, int nrows) {
    const int gw = C.bid * NWAVES + C.wave, NGW = C.G * NWAVES;
    if (gw >= nrows) return;
    f32x4 g[4];
#pragma unroll
    for (int j = 0; j < 2; ++j) { g[2 * j] = *(const f32x4*)(gain + 8 * C.lane + 512 * j); g[2 * j + 1] = *(const f32x4*)(gain + 8 * C.lane + 512 * j + 4); }
    NRow Rn = {}; nrow_issue<SRC_F32>(C, xl, xc, l, m_sh, m_sc, gw, Rn);
    for (int row = gw; row < nrows; row += NGW) {
        const NRow Rc = Rn;
        if (row + NGW < nrows) nrow_issue<SRC_F32>(C, xl, xc, l, m_sh, m_sc, row + NGW, Rn);
        float ss = 0.f;
#pragma unroll
        for (int j = 0; j < 4; ++j) ss += (Rc.x[j].x * Rc.x[j].x + Rc.x[j].y * Rc.x[j].y) + (Rc.x[j].z * Rc.x[j].z + Rc.x[j].w * Rc.x[j].w);
        const float rstd = rsqrtf(wave_sum(ss, C.lane) * (1.0f / D) + RMS_EPS);
#pragma unroll
        for (int j = 0; j < 2; ++j) { const int col = 8 * C.lane + 512 * j;
            const f32x4 y0 = Rc.x[2 * j] * rstd * g[2 * j] * (Rc.sc[2 * j] + 1.0f) + Rc.sh[2 * j], y1 = Rc.x[2 * j + 1] * rstd * g[2 * j + 1] * (Rc.sc[2 * j + 1] + 1.0f) + Rc.sh[2 * j + 1];
            if (H) { v4u w; w.x = pk2(y0.x, y0.y); w.y = pk2(y0.z, y0.w); w.z = pk2(y1.x, y1.y); w.w = pk2(y1.z, y1.w); *(v4u*)(H + (size_t)row * D + col) = w; }
            if (H8) { v2u w; w.x = pk4_fp8(y0.x, y0.y, y0.z, y0.w); w.y = pk4_fp8(y1.x, y1.y, y1.z, y1.w); *(v2u*)(H8 + (size_t)row * D + col) = w; } }
    }
}

constexpr int L_CS = 0;
constexpr int L_S0 = 20480;
constexpr int P72 = 72, P136 = 136;
DI void load_cs_table(const Ctx& C) {
    const bf16* cs = wsb(C, WS_CS64); LAS bf16* d = (LAS bf16*)(C.lds + L_CS);
    v4u t[2];
#pragma unroll
    for (int j = 0; j < 2; ++j) { const int i = C.tid + 512 * j, r = i >> 4, c8 = i & 15; t[j] = *(const v4u*)(cs + r * 128 + c8 * 8); }
#pragma unroll
    for (int j = 0; j < 2; ++j) { const int i = C.tid + 512 * j, r = i >> 4, c8 = i & 15; *(LAS v4u*)(d + r * P136 + c8 * 8) = t[j]; }
}
DI void slab_put(LAS bf16* slab, const bf16* rowp_chunk, int lane) { *(LAS v4u*)(slab + (lane >> 3) * 72 + (lane & 7) * 8) = *(const v4u*)rowp_chunk; }
DI unsigned slab_get(const LAS bf16* slab, int i, int lane) { return slab[i * 72 + lane]; }
DI void vt_decode(const Ctx& C, int u, int& b, int& h, int& row0, bf16*& dst) {
    const int d = C.lane, seg = C.wave;
    if (u < 4096) { b = u >> 9; h = (u >> 6) & 7; const int tb = u & 63; row0 = b * SEQ + tb * 64; dst = wsb(C, WS_VTL) + ((size_t)((b * 8 + h) * 64 + d)) * SEQ + tb * 64 + seg * 8; }
    else { const int uc = u - 4096; b = uc >> 5; h = (uc >> 2) & 7; const int tb = uc & 3; row0 = NLAT + b * CTXL + tb * 64; dst = wsb(C, WS_VTC) + ((size_t)((b * 8 + h) * 64 + d)) * CTXL + tb * 64 + seg * 8; }
}
DI void vt_load(const Ctx& C, int u, v4u (&r)[1]) {
    int b, h, row0; bf16* dst; vt_decode(C, u, b, h, row0, dst);
    r[0] = *(const v4u*)(wsb(C, WS_Z) + (size_t)(row0 + C.wave * 8 + (C.lane >> 3)) * INC + C_V + h * 64 + (C.lane & 7) * 8);
}
DI void vt_stage(const Ctx& C, const v4u (&r)[1]) {
    const int kl = C.lane >> 3, dg = C.lane & 7, seg = C.wave;
    LAS bf16* Tt = (LAS bf16*)(C.lds + L_S0 + 94208) + (8 * dg) * 72 + 8 * (seg ^ dg) + kl;
    const unsigned w[4] = {r[0].x, r[0].y, r[0].z, r[0].w};
#pragma unroll
    for (int i = 0; i < 8; ++i) Tt[i * 72] = (bf16)((i & 1) ? (w[i >> 1] >> 16) : (w[i >> 1] & 0xffffu));
}
DI void vt_flush(const Ctx& C, int u) {
    const int wv = C.wave, d = 8 * wv + (C.lane >> 3), p = C.lane & 7;
    const v4u x = *(const LAS v4u*)((const LAS bf16*)(C.lds + L_S0 + 94208) + d * 72 + 8 * (p ^ wv));
    bf16* dst;
    if (u < 4096) { const int b = u >> 9, h = (u >> 6) & 7, tb = u & 63; dst = wsb(C, WS_VTL) + ((size_t)((b * 8 + h) * 64 + d)) * SEQ + tb * 64 + p * 8; }
    else { const int uc = u - 4096, b = uc >> 5, h = (uc >> 2) & 7, tb = uc & 3; dst = wsb(C, WS_VTC) + ((size_t)((b * 8 + h) * 64 + d)) * CTXL + tb * 64 + p * 8; }
    *(v4u*)dst = x;
}
DI void fft1_load(const Ctx& C, int u, v4u (&r)[1]) {
    const int b = u >> 8, g = (u >> 6) & 3, n2 = u & 63, lane = C.lane, w = C.wave;
    r[0] = *(const v4u*)(wsb(C, WS_Z) + (size_t)(b * SEQ + (w * 8 + (lane >> 3)) * 64 + n2) * INC + C_FN + g * 64 + (lane & 7) * 8);
}
template <int PART> DI void fft1_unit(const Ctx& C, int u, const v4u (&r)[1]) {
    const int b = u >> 8, g = (u >> 6) & 3, n2 = u & 63, lane = C.lane, w = C.wave, fr = lane & 15, fq = lane >> 4;
    const bf16* Z = wsb(C, WS_Z); LAS bf16* UT = (LAS bf16*)(C.lds + L_S0 + 53248); const LAS bf16* CS = (const LAS bf16*)(C.lds + L_CS);
    if (PART == 0) __syncthreads();
    if (PART != 2) { LAS bf16* slab = (LAS bf16*)(C.lds + L_S0 + 63488) + w * 576; unsigned v[8];
      *(LAS v4u*)(slab + (lane >> 3) * 72 + (lane & 7) * 8) = r[0];
#pragma unroll
      for (int i = 0; i < 8; ++i) v[i] = slab_get(slab, i, lane);
      v4u x; x.x = v[0] | (v[1] << 16); x.y = v[2] | (v[3] << 16); x.z = v[4] | (v[5] << 16); x.w = v[6] | (v[7] << 16);
      *(LAS v4u*)(UT + lane * P72 + w * 8) = x; }
    if (PART == 0) __syncthreads();
    if (PART == 1) return;
    const int kt = w >> 1, k1 = kt * 16 + fr;
    float tc, ts; sincospif((float)(k1 * n2) * (1.0f / 2048.0f), &ts, &tc);
    bf16* t1r = wsb(C, WS_T1R) + ((size_t)((b * 4 + g) * 64 + k1)) * 4096 + n2 * 64; bf16* t1i = wsb(C, WS_T1I) + ((size_t)((b * 4 + g) * 64 + k1)) * 4096 + n2 * 64;
#pragma unroll
    for (int ci = 0; ci < 2; ++ci) { const int ct = 2 * (w & 1) + ci; f32x4 aR = {0.f, 0.f, 0.f, 0.f}, aI = {0.f, 0.f, 0.f, 0.f};
#pragma unroll
        for (int ks = 0; ks < 2; ++ks) { const bf16x8 a = ldfrag(UT, P72, ct * 16, ks * 32, lane), bc = ldfrag(CS, P136, kt * 16, ks * 32, lane), bs = ldfrag(CS, P136, kt * 16, 64 + ks * 32, lane);
            aR = mfma16(a, bc, aR); aI = mfma16(a, bs, aI); }
        const f32x4 re = aR * tc - aI * ts, im = -(aI * tc) - aR * ts;
        v2u x; x.x = pk2(re[0], re[1]); x.y = pk2(re[2], re[3]); *(v2u*)(t1r + ct * 16 + 4 * fq) = x;
        v2u y; y.x = pk2(im[0], im[1]); y.y = pk2(im[2], im[3]); *(v2u*)(t1i + ct * 16 + 4 * fq) = y; }
}
DI void fft2_load(const Ctx& C, int u, v4u (&r)[2]) {
    const int b = u >> 8, g = (u >> 6) & 3, k1 = u & 63, lane = C.lane, w = C.wave;
    const size_t base = ((size_t)((b * 4 + g) * 64 + k1)) * 4096 + (size_t)(w * 8 + (lane >> 3)) * 64 + (lane & 7) * 8;
    r[0] = *(const v4u*)(wsb(C, WS_T1R) + base); r[1] = *(const v4u*)(wsb(C, WS_T1I) + base);
}
DI void fft2_unit(const Ctx& C, int u, const v4u (&r)[2]) {
    const int b = u >> 8, g = (u >> 6) & 3, k1 = u & 63, lane = C.lane, w = C.wave, fr = lane & 15, fq = lane >> 4;
    LAS bf16* BR = (LAS bf16*)(C.lds + L_S0); LAS bf16* BI = BR + 64 * P136; LAS bf16* PP = BI + 64 * P136; const LAS bf16* CS = (const LAS bf16*)(C.lds + L_CS);
    { unsigned rr[8], m[8];
      LAS bf16* slr = (LAS bf16*)(C.lds + L_S0 + 53248) + w * 576; LAS bf16* sli = slr + 8 * 576;
      *(LAS v4u*)(slr + (lane >> 3) * 72 + (lane & 7) * 8) = r[0]; *(LAS v4u*)(sli + (lane >> 3) * 72 + (lane & 7) * 8) = r[1];
#pragma unroll
      for (int i = 0; i < 8; ++i) { rr[i] = slab_get(slr, i, lane); m[i] = slab_get(sli, i, lane); }
      v4u xr, xi, xn; xr.x = rr[0] | (rr[1] << 16); xr.y = rr[2] | (rr[3] << 16); xr.z = rr[4] | (rr[5] << 16); xr.w = rr[6] | (rr[7] << 16);
      xi.x = m[0] | (m[1] << 16); xi.y = m[2] | (m[3] << 16); xi.z = m[4] | (m[5] << 16); xi.w = m[6] | (m[7] << 16);
      xn = xr ^ 0x80008000u;
      *(LAS v4u*)(BR + lane * P136 + w * 8) = xr; *(LAS v4u*)(BR + lane * P136 + 64 + w * 8) = xi;
      *(LAS v4u*)(BI + lane * P136 + w * 8) = xi; *(LAS v4u*)(BI + lane * P136 + 64 + w * 8) = xn; }
    __syncthreads();
    const int kt = w >> 1;
#pragma unroll
    for (int ci = 0; ci < 2; ++ci) { const int ct = 2 * (w & 1) + ci; f32x4 aR = {0.f, 0.f, 0.f, 0.f}, aI = {0.f, 0.f, 0.f, 0.f};
#pragma unroll
        for (int ks = 0; ks < 4; ++ks) { const bf16x8 bq = ldfrag(CS, P136, kt * 16, ks * 32, lane); aR = mfma16(ldfrag(BR, P136, ct * 16, ks * 32, lane), bq, aR); aI = mfma16(ldfrag(BI, P136, ct * 16, ks * 32, lane), bq, aI); }
        v2u x; x.x = pk2(aR[0], aR[1]); x.y = pk2(aR[2], aR[3]); *(LAS v2u*)(PP + (kt * 16 + fr) * P136 + ct * 16 + 4 * fq) = x;
        v2u y; y.x = pk2(aI[0], aI[1]); y.y = pk2(aI[2], aI[3]); *(LAS v2u*)(PP + (kt * 16 + fr) * P136 + 64 + ct * 16 + 4 * fq) = y; }
    __syncthreads();
    bf16* MIX = wsb(C, WS_MIX); unsigned wq[2];
#pragma unroll
    for (int mi = 0; mi < 2; ++mi) { const int mt = 2 * (w & 1) + mi; f32x4 a = {0.f, 0.f, 0.f, 0.f};
#pragma unroll
        for (int ks = 0; ks < 4; ++ks) a = mfma16(ldfrag(CS, P136, mt * 16, ks * 32, lane), ldfrag(PP, P136, kt * 16, ks * 32, lane), a);
        a = a * (1.0f / 512.0f); wq[mi] = pk4_fp8(a[0], a[1], a[2], a[3]); }
    { const int k2 = kt * 16 + fr; const bool oq = fq & 1; const auto sw = __builtin_amdgcn_permlane16_swap(wq[0], wq[1], false, false);
      v2u o; o.x = sw[0]; o.y = sw[1];
      *(v2u*)((unsigned char*)MIX + (size_t)(b * SEQ + k1 + 64 * k2) * D + g * 64 + (2 * (w & 1) + (oq ? 1 : 0)) * 16 + 4 * (oq ? fq - 1 : fq)) = o; }
}
DI void cfft_unit(const Ctx& C, int u) {
    const int b = u >> 4, g = (u >> 2) & 3, kblk = u & 3, lane = C.lane, w = C.wave, fr = lane & 15, fq = lane >> 4;
    LAS bf16* UT = (LAS bf16*)(C.lds + L_S0); LAS bf16* PP = UT + 64 * 264; const LAS bf16* CS = (const LAS bf16*)(C.lds + L_CS);
    LAS bf16* slab = (LAS bf16*)(C.lds + L_S0 + 53248) + w * 576;
    const bf16* Z = wsb(C, WS_Z) + (size_t)(NLAT + b * CTXL) * INC + C_FN + g * 64;
    __syncthreads();
    v4u zz[4];
#pragma unroll
    for (int p = 0; p < 4; ++p) zz[p] = *(const v4u*)(Z + (size_t)(p * 64 + w * 8 + (lane >> 3)) * INC + (lane & 7) * 8);
#pragma unroll
    for (int p = 0; p < 4; ++p) { *(LAS v4u*)(slab + (lane >> 3) * 72 + (lane & 7) * 8) = zz[p]; unsigned v[8];
#pragma unroll
        for (int i = 0; i < 8; ++i) v[i] = slab_get(slab, i, lane);
        v4u x; x.x = v[0] | (v[1] << 16); x.y = v[2] | (v[3] << 16); x.z = v[4] | (v[5] << 16); x.w = v[6] | (v[7] << 16);
        *(LAS v4u*)(UT + lane * 264 + p * 64 + w * 8) = x; }
    __syncthreads();
    const int kt = w >> 1; const bf16* frow = wsb(C, WS_CS256) + (size_t)(kblk * 64 + kt * 16 + fr) * 512 + 8 * fq;
#pragma unroll
    for (int ci = 0; ci < 2; ++ci) { const int ct = 2 * (w & 1) + ci; f32x4 aR = {0.f, 0.f, 0.f, 0.f}, aI = {0.f, 0.f, 0.f, 0.f};
#pragma unroll
        for (int ks = 0; ks < 8; ++ks) { const bf16x8 a = ldfrag(UT, 264, ct * 16, ks * 32, lane); aR = mfma16(a, *(const bf16x8*)(frow + ks * 32), aR); aI = mfma16(a, *(const bf16x8*)(frow + 256 + ks * 32), aI); }
        const f32x4 nI = -aI;
        v2u x; x.x = pk2(aR[0], aR[1]); x.y = pk2(aR[2], aR[3]); *(LAS v2u*)(PP + (kt * 16 + fr) * P136 + ct * 16 + 4 * fq) = x;
        v2u y; y.x = pk2(nI[0], nI[1]); y.y = pk2(nI[2], nI[3]); *(LAS v2u*)(PP + (kt * 16 + fr) * P136 + 64 + ct * 16 + 4 * fq) = y; }
    __syncthreads();
    bf16* MIX = wsb(C, WS_MIX);
#pragma unroll
    for (int mi = 0; mi < 2; ++mi) { const int mt = 2 * (w & 1) + mi; f32x4 a = {0.f, 0.f, 0.f, 0.f};
#pragma unroll
        for (int ks = 0; ks < 4; ++ks) a = mfma16(ldfrag(CS, P136, mt * 16, ks * 32, lane), ldfrag(PP, P136, kt * 16, ks * 32, lane), a);
        a = a * (1.0f / 128.0f);
        *(unsigned*)((unsigned char*)MIX + (size_t)(NLAT + b * CTXL + kblk * 64 + kt * 16 + fr) * D + g * 64 + mt * 16 + 4 * fq) = pk4_fp8(a[0], a[1], a[2], a[3]); }
}
DI void cfft1_item(const Ctx& C, int it) {
    LAS float* tab = (LAS float*)(C.lds + L_S0);
    __syncthreads();
    if (C.tid < 256) { float s, c; sincospif((float)C.tid * (1.0f / 128.0f), &s, &c); tab[2 * C.tid] = c; tab[2 * C.tid + 1] = s; }
    __syncthreads();
    const int idx = it * 512 + C.tid, c = idx & 63, k = (idx >> 6) & 255, bg = idx >> 14, b = bg >> 2, g = bg & 3;
    const bf16* src = wsb(C, WS_Z) + (size_t)(NLAT + b * CTXL) * INC + C_FN + g * 64 + c;
    float pr = 0.f, pi = 0.f;
#pragma unroll 8
    for (int n = 0; n < 256; ++n) { const float uv = bf2f(src[(size_t)n * INC]); const int a = (k * n) & 255; pr += uv * tab[2 * a]; pi -= uv * tab[2 * a + 1]; }
    float* cp = wsf(C, WS_CP) + (size_t)idx * 2; cp[0] = pr; cp[1] = pi;
}
DI void cfft2_item(const Ctx& C, int it) {
    LAS float* tab = (LAS float*)(C.lds + L_S0 + 4096);
    __syncthreads();
    if (C.tid < 64) { float s, c; sincospif((float)C.tid * (1.0f / 32.0f), &s, &c); tab[2 * C.tid] = c; tab[2 * C.tid + 1] = s; }
    __syncthreads();
    const int idx = it * 512 + C.tid, m = idx & 63, k = (idx >> 6) & 255, bg = idx >> 14, b = bg >> 2, g = bg & 3;
    const float* cp = wsf(C, WS_CP) + (size_t)(idx - m) * 2; float y = 0.f;
#pragma unroll 8
    for (int c = 0; c < 64; ++c) { const int a = (m * c) & 63; y += cp[2 * c] * tab[2 * a] + cp[2 * c + 1] * tab[2 * a + 1]; }
    wsb(C, WS_MIX)[(size_t)(NLAT + b * CTXL + k) * D + g * 64 + m] = (bf16)f2bf(y * (1.0f / 128.0f));
}

DI int hg_row(int b, int p, int dir) { return dir == 0 ? (p < CTXL ? NLAT + b * CTXL + p : b * SEQ + (p - CTXL)) : (p < CTXL ? NLAT + b * CTXL + (CTXL - 1 - p) : b * SEQ + (SEQ - 1 - (p - CTXL))); }
DI float hg_lb(const Ctx& C, int l, int dir, int ch) {
    if (l == 0) return 0.f;
    const float v0 = inp(C, I_HGLB)[dir * 256 + ch], v1 = inp(C, I_HGLB)[512 + dir * 256 + ch];
    return 1.0f / (1.0f + __expf(v0 - v1));
}
DI void hgrn1_load(const Ctx& C, int u, v4u (&r)[2]) {
    const int chain = u / NCHUNK, c = u - chain * NCHUNK, b = chain >> 3, h = (chain >> 1) & 3, dir = chain & 1, lane = C.lane, w = C.wave;
    const size_t row = (size_t)hg_row(b, c * 64 + w * 8 + (lane >> 3), dir) * INC + h * 64 + (lane & 7) * 8; const bf16* Z = wsb(C, WS_Z);
    r[0] = *(const v4u*)(Z + row + (dir ? C_HB : C_HF)); r[1] = *(const v4u*)(Z + row + C_HI);
}
DI void hgrn1_unit(const Ctx& C, int l, int u, const v4u (&r)[2], bool do_f, int uf, const v4u (&rf)[1], int par) {
    const int chain = u / NCHUNK, c = u - chain * NCHUNK, b = chain >> 3, h = (chain >> 1) & 3, dir = chain & 1, lane = C.lane, w = C.wave, fr = lane & 15, fq = lane >> 4;
    const bf16* Z = wsb(C, WS_Z);
    LAS float* TOT = (LAS float*)(C.lds + L_S0 + (par ? 24576 : 0)); LAS bf16* KD = (LAS bf16*)(C.lds + L_S0 + (par ? 73728 : 4096)); LAS bf16* VT = (LAS bf16*)(C.lds + L_S0 + (par ? 82944 : 13312));
    const float lb = ((const LAS float*)(C.lds + L_S0 + 28672))[dir * 256 + h * 64 + lane];
    float f[8], cs[8]; unsigned vv[8]; float run = 0.f;
    LAS bf16* slz = (LAS bf16*)(C.lds + L_S0 + 32768) + w * 576; LAS bf16* slv = slz + 8 * 576;
    *(LAS v4u*)(slz + (lane >> 3) * 72 + (lane & 7) * 8) = r[0]; *(LAS v4u*)(slv + (lane >> 3) * 72 + (lane & 7) * 8) = r[1];
#pragma unroll
    for (int i = 0; i < 8; ++i) { const float z = bf2f(slab_get(slz, i, lane)); vv[i] = slab_get(slv, i, lane);
        f[i] = lb + (1.0f - lb) * sigm(z); run += __logf(f[i]); cs[i] = run; }
    TOT[w * 64 + lane] = run;
    { v4u x; x.x = vv[0] | (vv[1] << 16); x.y = vv[2] | (vv[3] << 16); x.z = vv[4] | (vv[5] << 16); x.w = vv[6] | (vv[7] << 16); *(LAS v4u*)(VT + lane * P72 + w * 8) = x; }
    __syncthreads();
    vt_flush(C, u);
    if (do_f) fft1_unit<1>(C, uf, rf);
    float off = 0.f, blast = 0.f;
#pragma unroll
    for (int s = 0; s < 8; ++s) { const float t = TOT[s * 64 + lane]; blast += t; if (s < w) off += t; }
    float kd[8];
#pragma unroll
    for (int i = 0; i < 8; ++i) kd[i] = (1.0f - f[i]) * __expf(blast - (off + cs[i]));
    { v4u x; x.x = pk2(kd[0], kd[1]); x.y = pk2(kd[2], kd[3]); x.z = pk2(kd[4], kd[5]); x.w = pk2(kd[6], kd[7]); *(LAS v4u*)(KD + lane * P72 + w * 8) = x; }
    if (w == 0) wsf(C, WS_HDEC)[(size_t)u * 64 + lane] = __expf(blast);
    __syncthreads();
    if (do_f) fft1_unit<2>(C, uf, rf);
    const int vt = w >> 1; float* HL = wsf(C, WS_HL) + (size_t)u * 4096;
#pragma unroll
    for (int ki = 0; ki < 2; ++ki) { const int kt = 2 * (w & 1) + ki; f32x4 a = {0.f, 0.f, 0.f, 0.f};
#pragma unroll
        for (int ks = 0; ks < 2; ++ks) a = mfma16(ldfrag(KD, P72, kt * 16, ks * 32, lane), ldfrag(VT, P72, vt * 16, ks * 32, lane), a);
        *(f32x4*)(HL + (vt * 16 + fr) * 64 + kt * 16 + 4 * fq) = a; }
}
DI void hgrn2_item(const Ctx& C, int it) {
    const int idx = it * 512 + C.tid, chain = idx >> 12, vk = idx & 4095, k = vk & 63;
    const float* HL = wsf(C, WS_HL) + (size_t)chain * NCHUNK * 4096 + vk; const float* DEC = wsf(C, WS_HDEC) + (size_t)chain * NCHUNK * 64 + k; bf16* SP = wsb(C, WS_HSP) + (size_t)chain * NCHUNK * 4096 + vk;
    float S = 0.f;
    float hn[17], dn[17];
#pragma unroll
    for (int j = 0; j < 17; ++j) { hn[j] = HL[(size_t)j * 4096]; dn[j] = DEC[j * 64]; }
    for (int c0 = 0; c0 < NCHUNK; c0 += 17) {
        float hl[17], dc[17];
#pragma unroll
        for (int j = 0; j < 17; ++j) { hl[j] = hn[j]; dc[j] = dn[j]; }
        if (c0 + 17 < NCHUNK) {
#pragma unroll
            for (int j = 0; j < 17; ++j) { hn[j] = HL[(size_t)(c0 + 17 + j) * 4096]; dn[j] = DEC[(c0 + 17 + j) * 64]; } }
#pragma unroll
        for (int j = 0; j < 17; ++j) { SP[(size_t)(c0 + j) * 4096] = (bf16)f2bf(S); S = dc[j] * S + hl[j]; }
    }
}
DI void hgrn3_load(const Ctx& C, int u, v4u (&r)[4]) {
    const int cl = u % NCHUNK, bh = u / NCHUNK, b = bh >> 2, h = bh & 3, lane = C.lane, w = C.wave;
    const int row0 = cl >= 64 ? NLAT + b * CTXL + (cl - 64) * 64 : b * SEQ + cl * 64; const bf16* Z = wsb(C, WS_Z);
    const size_t row = (size_t)(row0 + w * 8 + (lane >> 3)) * INC + h * 64 + (lane & 7) * 8;
    r[0] = *(const v4u*)(Z + row + C_HF); r[1] = *(const v4u*)(Z + row + C_HB); r[2] = *(const v4u*)(Z + row + C_HQ); r[3] = *(const v4u*)(Z + row + C_HI);
}
DI void hgrn3_unit(const Ctx& C, int l, int u, const v4u (&r)[4]) {
    const int cl = u % NCHUNK, bh = u / NCHUNK, b = bh >> 2, h = bh & 3, lane = C.lane, w = C.wave, fr = lane & 15, fq = lane >> 4;
    const bool isctx = cl >= 64; const int cc = cl - 64;
    const int row0 = isctx ? NLAT + b * CTXL + cc * 64 : b * SEQ + cl * 64;
    const int cF = isctx ? cc : 4 + cl, cB = isctx ? 3 - cc : 4 + (63 - cl);
    const size_t uF = (size_t)(bh * 2) * NCHUNK + cF, uB = (size_t)(bh * 2 + 1) * NCHUNK + cB;
    const bf16* Z = wsb(C, WS_Z);
    unsigned char LAS* base = C.lds + L_S0;
    LAS float* TOTF = (LAS float*)base; LAS float* TOTB = (LAS float*)(base + 2048);
    LAS bf16* QtF = (LAS bf16*)(base + 4096); LAS bf16* KtF = QtF + 64 * P72; LAS bf16* QtB = KtF + 64 * P72; LAS bf16* KtB = QtB + 64 * P72;
    LAS bf16* QhF = KtB + 64 * P72; LAS bf16* QhB = QhF + 64 * P72; LAS bf16* VT = QhB + 64 * P72; LAS bf16* AA = VT + 64 * P72;
    LAS float* OO = (LAS float*)(AA + 64 * P72);
    const float lbF = ((const LAS float*)(C.lds + L_S0 + 106496))[h * 64 + lane], lbB = ((const LAS float*)(C.lds + L_S0 + 106496))[256 + h * 64 + lane];
    float fF[8], fB[8], cF_[8], cB_[8], q[8]; unsigned vv[8];
    const bf16* SPF = wsb(C, WS_HSP) + uF * 4096; const bf16* SPB = wsb(C, WS_HSP) + uB * 4096;
    bf16x8 sfF[2][2], sfB[2][2];
#pragma unroll
    for (int vi = 0; vi < 2; ++vi)
#pragma unroll
        for (int ks = 0; ks < 2; ++ks) { const int vt = 2 * (w & 1) + vi; sfF[vi][ks] = *(const bf16x8*)(SPF + (vt * 16 + fr) * 64 + ks * 32 + 8 * fq); sfB[vi][ks] = *(const bf16x8*)(SPB + (vt * 16 + fr) * 64 + ks * 32 + 8 * fq); }
    const v4u hw = *(const v4u*)(Z + (size_t)(row0 + (C.tid >> 3)) * INC + C_HG + h * 64 + (C.tid & 7) * 8);
    const f32x4 g0 = *(const f32x4*)(inp(C, I_HGNG) + l * 64 + (C.tid & 7) * 8), g1 = *(const f32x4*)(inp(C, I_HGNG) + l * 64 + (C.tid & 7) * 8 + 4);
    { LAS bf16* sl = QtF + w * (4 * 576); const int so = (lane >> 3) * 72 + (lane & 7) * 8;
      *(LAS v4u*)(sl + so) = r[0]; *(LAS v4u*)(sl + 576 + so) = r[1]; *(LAS v4u*)(sl + 2 * 576 + so) = r[2]; *(LAS v4u*)(sl + 3 * 576 + so) = r[3];
#pragma unroll
      for (int i = 0; i < 8; ++i) { const float zf = bf2f(slab_get(sl, i, lane)), zb = bf2f(slab_get(sl + 576, i, lane)), hq = bf2f(slab_get(sl + 2 * 576, i, lane)); vv[i] = slab_get(sl + 3 * 576, i, lane);
        fF[i] = lbF + (1.0f - lbF) * sigm(zf); fB[i] = lbB + (1.0f - lbB) * sigm(zb); q[i] = hq * sigm(hq); } }
    { float run = 0.f;
#pragma unroll
      for (int i = 0; i < 8; ++i) { run += __logf(fF[i]); cF_[i] = run; }
      float runb = 0.f;
#pragma unroll
      for (int i = 7; i >= 0; --i) { runb += __logf(fB[i]); cB_[i] = runb; }
      TOTF[w * 64 + lane] = run; TOTB[w * 64 + lane] = runb; }
    { v4u x; x.x = vv[0] | (vv[1] << 16); x.y = vv[2] | (vv[3] << 16); x.z = vv[4] | (vv[5] << 16); x.w = vv[6] | (vv[7] << 16); *(LAS v4u*)(VT + lane * P72 + w * 8) = x; }
    __syncthreads();
    float offF = 0.f, offB = 0.f, mF = 0.f, mB = 0.f;
#pragma unroll
    for (int s = 0; s < 8; ++s) { const float tf = TOTF[s * 64 + lane], tb = TOTB[s * 64 + lane]; if (s < w) offF += tf; if (s > w) offB += tb; if (s < 4) mF += tf; else mB += tb; }
#pragma unroll
    for (int i = 0; i < 8; ++i) { const int t = w * 8 + i; const float bF = offF + cF_[i], bB = offB + cB_[i];
        QtF[t * P72 + lane] = (bf16)f2bf(q[i] * __expf(bF - mF)); KtF[t * P72 + lane] = (bf16)f2bf((1.0f - fF[i]) * __expf(mF - bF));
        QtB[t * P72 + lane] = (bf16)f2bf(q[i] * __expf(bB - mB)); KtB[t * P72 + lane] = (bf16)f2bf((1.0f - fB[i]) * __expf(mB - bB));
        QhF[t * P72 + lane] = (bf16)f2bf(q[i] * __expf(bF)); QhB[t * P72 + lane] = (bf16)f2bf(q[i] * __expf(bB)); }
    __syncthreads();
    const int tt = w >> 1, tau = tt * 16 + fr;
#pragma unroll
    for (int si = 0; si < 2; ++si) { const int st = 2 * (w & 1) + si; f32x4 aF = {0.f, 0.f, 0.f, 0.f}, aB = {0.f, 0.f, 0.f, 0.f};
#pragma unroll
        for (int ks = 0; ks < 2; ++ks) { aF = mfma16(ldfrag(KtF, P72, st * 16, ks * 32, lane), ldfrag(QtF, P72, tt * 16, ks * 32, lane), aF);
                                         aB = mfma16(ldfrag(KtB, P72, st * 16, ks * 32, lane), ldfrag(QtB, P72, tt * 16, ks * 32, lane), aB); }
        float o[4];
#pragma unroll
        for (int i = 0; i < 4; ++i) { const int sg = st * 16 + 4 * fq + i; o[i] = (sg <= tau ? aF[i] : 0.f) + (sg >= tau ? aB[i] : 0.f); }
        v2u x; x.x = pk2(o[0], o[1]); x.y = pk2(o[2], o[3]); *(LAS v2u*)(AA + tau * P72 + st * 16 + 4 * fq) = x; }
    __syncthreads();
#pragma unroll
    for (int vi = 0; vi < 2; ++vi) { const int vt = 2 * (w & 1) + vi; f32x4 a = {0.f, 0.f, 0.f, 0.f};
#pragma unroll
        for (int ks = 0; ks < 2; ++ks) { a = mfma16(ldfrag(VT, P72, vt * 16, ks * 32, lane), ldfrag(AA, P72, tt * 16, ks * 32, lane), a);
            a = mfma16(sfF[vi][ks], ldfrag(QhF, P72, tt * 16, ks * 32, lane), a);
            a = mfma16(sfB[vi][ks], ldfrag(QhB, P72, tt * 16, ks * 32, lane), a); }
        *(LAS f32x4*)(OO + tau * 68 + vt * 16 + 4 * fq) = a; }
    __syncthreads();
    { const int t = C.tid >> 3, part = C.tid & 7; const f32x4 o0 = *(const LAS f32x4*)(OO + t * 68 + part * 8), o1 = *(const LAS f32x4*)(OO + t * 68 + part * 8 + 4);
      float ss = (o0.x * o0.x + o0.y * o0.y) + (o0.z * o0.z + o0.w * o0.w) + (o1.x * o1.x + o1.y * o1.y) + (o1.z * o1.z + o1.w * o1.w);
      ss += shx(ss, 1, C.lane); ss += shx(ss, 2, C.lane); ss += shx(ss, 4, C.lane);
      const float rstd = rsqrtf(ss * (1.0f / 64.0f) + RMS_EPS);
      float hgv[8] = {bflo(hw.x), bfhi(hw.x), bflo(hw.y), bfhi(hw.y), bflo(hw.z), bfhi(hw.z), bflo(hw.w), bfhi(hw.w)};
      float y[8];
#pragma unroll
      for (int j = 0; j < 4; ++j) { y[j] = o0[j] * rstd * g0[j] * hgv[j] * sigm(hgv[j]); y[4 + j] = o1[j] * rstd * g1[j] * hgv[4 + j] * sigm(hgv[4 + j]); }
      v2u x; x.x = pk4_fp8(y[0], y[1], y[2], y[3]); x.y = pk4_fp8(y[4], y[5], y[6], y[7]);
      *(v2u*)(C.ws + WS_MIX + (size_t)(row0 + t) * D + 768 + h * 64 + part * 8) = x; }
}

template <bool LOCAL, bool CL> DI void attn_wave_unit(const Ctx& C, const LAS float* rpb, const LAS bf16* Kc, const LAS bf16* VTc, int b, int h, int r, int qg) {
    const int lane = C.lane, fr = lane & 15, fq = lane >> 4;
    const bf16* Z = wsb(C, WS_Z);
    const int qrow = LOCAL ? b * SEQ + r * 64 + qg * 16 + fr : NLAT + b * CTXL + qg * 16 + fr;
    const bf16* qp = Z + (size_t)qrow * INC + C_Q + h * 64 + 8 * fq;
    const bf16x8 q0 = *(const bf16x8*)qp, q1 = *(const bf16x8*)(qp + 32);
    const int kr0 = r < 4 ? 0 : (r > 60 ? 56 : r - 4);
    const int wbase = qg == 0 ? 0 : (qg == 1 ? 8 : (qg == 2 ? 24 : 32));
    const int keyc = 8 * (fr >> 2) + (fr & 3);
    f32x4 O[4]; float sum = 0.f;
#pragma unroll
    for (int dt = 0; dt < 4; ++dt) O[dt] = (f32x4){0.f, 0.f, 0.f, 0.f};
    bf16x8 kf[8][4];
    if (LOCAL) { const unsigned klane = (unsigned)(keyc * INC + 8 * fq);
#pragma unroll
      for (int kr = 0; kr < 4; ++kr) { const bf16* kp = (Z + (size_t)(b * SEQ + (kr0 + kr) * 64 + wbase) * INC + C_K + h * 64) + klane;
          kf[kr][0] = *(const bf16x8*)kp; kf[kr][1] = *(const bf16x8*)(kp + 32); kf[kr][2] = *(const bf16x8*)(kp + 4 * INC); kf[kr][3] = *(const bf16x8*)(kp + 4 * INC + 32); }
      __builtin_amdgcn_sched_barrier(0); }
    { bf16x8 P[8];
      const bf16* vtc = wsb(C, WS_VTC) + ((size_t)((b * 8 + h) * 64 + fr)) * CTXL + 8 * fq;
      bf16x8 kc[4];
      if (CL) { const LAS bf16* kp = Kc + keyc * 72 + 8 * fq; kc[0] = *(const LAS bf16x8*)kp; kc[1] = *(const LAS bf16x8*)(kp + 32); kc[2] = *(const LAS bf16x8*)(kp + 4 * 72); kc[3] = *(const LAS bf16x8*)(kp + 4 * 72 + 32); }
#pragma unroll
      for (int cb = 0; cb < 8; ++cb) { f32x4 s0 = {0.f, 0.f, 0.f, 0.f}, s1 = {0.f, 0.f, 0.f, 0.f};
          if (CL) { const bf16x8 k0 = kc[0], k1 = kc[1], k2 = kc[2], k3 = kc[3];
                    if (cb < 7) { const LAS bf16* kp = Kc + ((cb + 1) * 32 + keyc) * 72 + 8 * fq; kc[0] = *(const LAS bf16x8*)kp; kc[1] = *(const LAS bf16x8*)(kp + 32); kc[2] = *(const LAS bf16x8*)(kp + 4 * 72); kc[3] = *(const LAS bf16x8*)(kp + 4 * 72 + 32); }
                    __builtin_amdgcn_sched_barrier(0);
                    s0 = mfma16(k0, q0, s0); s0 = mfma16(k1, q1, s0); s1 = mfma16(k2, q0, s1); s1 = mfma16(k3, q1, s1); }
          else { const bf16* kp = Z + (size_t)(NLAT + b * CTXL + cb * 32 + keyc) * INC + C_K + h * 64 + 8 * fq; s0 = mfma16(*(const bf16x8*)kp, q0, s0); s0 = mfma16(*(const bf16x8*)(kp + 32), q1, s0);
                 s1 = mfma16(*(const bf16x8*)(kp + 4 * INC), q0, s1); s1 = mfma16(*(const bf16x8*)(kp + 4 * INC + 32), q1, s1); }
          float p[8];
#pragma unroll
          for (int i = 0; i < 4; ++i) { p[i] = __builtin_amdgcn_exp2f(fminf(s0[i] * (0.125f * LOG2E), 60.0f)); p[4 + i] = __builtin_amdgcn_exp2f(fminf(s1[i] * (0.125f * LOG2E), 60.0f)); }
#pragma unroll
          for (int i = 0; i < 8; ++i) sum += p[i];
          v4u x; x.x = pk2(p[0], p[1]); x.y = pk2(p[2], p[3]); x.z = pk2(p[4], p[5]); x.w = pk2(p[6], p[7]); P[cb] = __builtin_bit_cast(bf16x8, x); }
      if (LOCAL) { const unsigned klane = (unsigned)(keyc * INC + 8 * fq);
          __builtin_amdgcn_sched_barrier(0);
#pragma unroll
          for (int kr = 4; kr < 8; ++kr) { const bf16* kp = (Z + (size_t)(b * SEQ + (kr0 + kr) * 64 + wbase) * INC + C_K + h * 64) + klane;
              kf[kr][0] = *(const bf16x8*)kp; kf[kr][1] = *(const bf16x8*)(kp + 32); kf[kr][2] = *(const bf16x8*)(kp + 4 * INC); kf[kr][3] = *(const bf16x8*)(kp + 4 * INC + 32); }
          __builtin_amdgcn_sched_barrier(0); }
      if (CL) {
#pragma unroll
          for (int dt = 0; dt < 4; ++dt) { bf16x8 vc[8];
#pragma unroll
              for (int cb = 0; cb < 8; ++cb) vc[cb] = *(const LAS bf16x8*)(VTc + (dt * 16 + fr) * 264 + cb * 32 + 8 * fq);
              __builtin_amdgcn_sched_barrier(0);
#pragma unroll
              for (int cb = 0; cb < 8; ++cb) O[dt] = mfma16(vc[cb], P[cb], O[dt]);
              __builtin_amdgcn_sched_barrier(0); }
      } else {
#pragma unroll
      for (int dt = 0; dt < 4; ++dt)
#pragma unroll
          for (int cb = 0; cb < 8; ++cb) O[dt] = mfma16(*(const bf16x8*)(vtc + (size_t)dt * 16 * CTXL + cb * 32), P[cb], O[dt]); } }
    if (LOCAL) { bf16x8 P[8];
      __builtin_amdgcn_sched_barrier(0);
      const int qc = qg * 16 + fr; const int cs = qc < 8 ? 0 : (qc > 56 ? 48 : qc - 8);
      const bf16* vtlu = wsb(C, WS_VTL) + (size_t)((b * 8 + h) * 64) * SEQ + wbase; const unsigned vlane = (unsigned)(fr * SEQ + 8 * fq);
#pragma unroll
      for (int kr = 0; kr < 8; ++kr) {
          f32x4 s0 = {0.f, 0.f, 0.f, 0.f}, s1 = {0.f, 0.f, 0.f, 0.f};
          s0 = mfma16(kf[kr][0], q0, s0); s0 = mfma16(kf[kr][1], q1, s0); s1 = mfma16(kf[kr][2], q0, s1); s1 = mfma16(kf[kr][3], q1, s1);
          const int dr = kr0 + kr - r + 7; const LAS float* bp = rpb + h * 465 + dr * 31; float p[8];
#pragma unroll
          for (int i = 0; i < 4; ++i) {
              { const int kc = wbase + 8 * fq + i; const float ok = (kc >= cs && kc < cs + 16) ? 1.0f : 0.0f; int dc = kc - qc + 15; dc = dc < 0 ? 0 : (dc > 30 ? 30 : dc);
                p[i] = ok * __builtin_amdgcn_exp2f(fminf((s0[i] * 0.125f + bp[dc]) * LOG2E, 60.0f)); }
              { const int kc = wbase + 8 * fq + 4 + i; const float ok = (kc >= cs && kc < cs + 16) ? 1.0f : 0.0f; int dc = kc - qc + 15; dc = dc < 0 ? 0 : (dc > 30 ? 30 : dc);
                p[4 + i] = ok * __builtin_amdgcn_exp2f(fminf((s1[i] * 0.125f + bp[dc]) * LOG2E, 60.0f)); } }
#pragma unroll
          for (int i = 0; i < 8; ++i) sum += p[i];
          v4u x; x.x = pk2(p[0], p[1]); x.y = pk2(p[2], p[3]); x.z = pk2(p[4], p[5]); x.w = pk2(p[6], p[7]); P[kr] = __builtin_bit_cast(bf16x8, x); }
      __builtin_amdgcn_sched_barrier(0);
      bf16x8 vf[4][8];
#pragma unroll
      for (int dt = 0; dt < 4; ++dt)
#pragma unroll
          for (int kr = 0; kr < 8; ++kr) vf[dt][kr] = *(const bf16x8*)((vtlu + (size_t)dt * 16 * SEQ + (kr0 + kr) * 64) + vlane);
      __builtin_amdgcn_sched_barrier(0);
#pragma unroll
      for (int dt = 0; dt < 4; ++dt)
#pragma unroll
          for (int kr = 0; kr < 8; ++kr) O[dt] = mfma16(vf[dt][kr], P[kr], O[dt]); }
    sum += shx(sum, 16, lane); sum += shx(sum, 32, lane);
    const float inv = 1.0f / sum;
    unsigned w[4];
#pragma unroll
    for (int dt = 0; dt < 4; ++dt) { const f32x4 o = O[dt] * inv; w[dt] = pk4_fp8(o[0], o[1], o[2], o[3]); }
    const auto s01 = __builtin_amdgcn_permlane16_swap(w[0], w[1], false, false), s23 = __builtin_amdgcn_permlane16_swap(w[2], w[3], false, false);
    const auto t0 = __builtin_amdgcn_permlane32_swap(s01[0], s23[0], false, false), t1 = __builtin_amdgcn_permlane32_swap(s01[1], s23[1], false, false);
    v4u ov; ov.x = t0[0]; ov.y = t1[0]; ov.z = t0[1]; ov.w = t1[1];
    *(v4u*)(C.ws + WS_MIX + (size_t)qrow * D + 256 + h * 64 + 16 * fq) = ov;
}

DI void attn_phase(const Ctx& C, int l, bool with_ctx_queries) {
    const LAS float* rpb = (const LAS float*)(C.lds + 116096);
    if (C.G == 256) {
        LAS bf16* Kc = (LAS bf16*)(C.lds + L_S0); LAS bf16* VTc = Kc + 256 * 72;
        const int bh = C.bid >> 2, q = C.bid & 3, b = bh >> 3, h = bh & 7;
        __syncthreads();
        const bf16* Z = wsb(C, WS_Z); const bf16* vtc = wsb(C, WS_VTC) + (size_t)(bh * 64) * CTXL;
        v4u tk[4], tv[4];
#pragma unroll
        for (int i = 0; i < 4; ++i) { const int ch = C.tid + 512 * i, j = ch >> 3, c8 = ch & 7; tk[i] = *(const v4u*)(Z + (size_t)(NLAT + b * CTXL + j) * INC + C_K + h * 64 + c8 * 8); }
#pragma unroll
        for (int i = 0; i < 4; ++i) { const int ch = C.tid + 512 * i, d = ch >> 5, c8 = ch & 31; tv[i] = *(const v4u*)(vtc + (size_t)d * CTXL + c8 * 8); }
#pragma unroll
        for (int i = 0; i < 4; ++i) { const int ch = C.tid + 512 * i, j = ch >> 3, c8 = ch & 7; *(LAS v4u*)(Kc + j * 72 + c8 * 8) = tk[i]; }
#pragma unroll
        for (int i = 0; i < 4; ++i) { const int ch = C.tid + 512 * i, d = ch >> 5, c8 = ch & 31; *(LAS v4u*)(VTc + d * 264 + c8 * 8) = tv[i]; }
        __syncthreads();
        for (int u = C.wave; u < 64; u += NWAVES) attn_wave_unit<true, true>(C, rpb, Kc, VTc, b, h, 16 * q + (u >> 2), u & 3);
        if (with_ctx_queries && C.wave < 4) attn_wave_unit<false, true>(C, rpb, Kc, VTc, b, h, 0, 4 * q + C.wave);
    } else {
        const int gw = C.bid * NWAVES + C.wave, NGW = C.G * NWAVES;
        for (int wu = gw; wu < BATCH * 64 * 8 * 4; wu += NGW) { const int qg = wu & 3, h = (wu >> 2) & 7, r = (wu >> 5) & 63, b = wu >> 11; attn_wave_unit<true, false>(C, rpb, nullptr, nullptr, b, h, r, qg); }
        if (with_ctx_queries) for (int wu = gw; wu < BATCH * 8 * 16; wu += NGW) { const int qg = wu & 15, h = (wu >> 4) & 7, b = wu >> 7; attn_wave_unit<false, false>(C, rpb, nullptr, nullptr, b, h, 0, qg); }
    }
}

constexpr int L_RPB = 116096;

DI void topk_phase(const Ctx& C, int l, int nrow) {
    LAS unsigned* lcnt = (LAS unsigned*)C.lds; LAS unsigned* lbase = lcnt + 256; LAS float* lbias = (LAS float*)(lcnt + 512);
    LAS float* tile = (LAS float*)(C.lds + L_S0) + C.wave * (64 * 33);
    const int lane = C.lane;
    __syncthreads();
    if (C.tid < 256) { lcnt[C.tid] = 0u; lbias[C.tid] = inp(C, I_BR)[l * 256 + C.tid]; }
    __syncthreads();
    const int gw = C.bid * NWAVES + C.wave, NGW = C.G * NWAVES, nblk = nrow >> 6;
    const float* SC = wsf(C, WS_SC);
    for (int t = gw; t < nblk; t += NGW) {
        const int row0 = t * 64, row = row0 + lane;
        unsigned top[8];
#pragma unroll
        for (int k = 0; k < 8; ++k) top[k] = 0u;
        f32x4 vn[8];
#pragma unroll
        for (int i = 0; i < 8; ++i) vn[i] = *(const f32x4*)(SC + (size_t)(row0 + i * 8 + (lane >> 3)) * 256 + (lane & 7) * 4);
        for (int ch = 0; ch < 8; ++ch) {
            f32x4 v[8];
#pragma unroll
            for (int i = 0; i < 8; ++i) v[i] = vn[i];
            if (ch < 7) {
#pragma unroll
                for (int i = 0; i < 8; ++i) vn[i] = *(const f32x4*)(SC + (size_t)(row0 + i * 8 + (lane >> 3)) * 256 + (ch + 1) * 32 + (lane & 7) * 4); }
#pragma unroll
            for (int i = 0; i < 8; ++i) { LAS float* d = tile + (i * 8 + (lane >> 3)) * 33 + (lane & 7) * 4; d[0] = v[i][0]; d[1] = v[i][1]; d[2] = v[i][2]; d[3] = v[i][3]; }
#pragma unroll
            for (int j = 0; j < 32; ++j) { const float x = tile[lane * 33 + j]; const float sel = sigm(x) + lbias[ch * 32 + j] + 2.0f;
                unsigned key = (__float_as_uint(sel) & 0xFFFFFF00u) | (unsigned)(255 - (ch * 32 + j));
#pragma unroll
                for (int k = 0; k < 8; ++k) { const unsigned hi = key > top[k] ? key : top[k], lo = key > top[k] ? top[k] : key; top[k] = hi; key = lo; } }
        }
        int e[8]; float g[8]; float gsum = 0.f;
#pragma unroll
        for (int k = 0; k < 8; ++k) { e[k] = 255 - (int)(top[k] & 255u); g[k] = SC[(size_t)row * 256 + e[k]]; }
        __builtin_amdgcn_sched_barrier(0);
#pragma unroll
        for (int k = 0; k < 8; ++k) { g[k] = sigm(g[k]); gsum += g[k]; }
        const float sc = 2.5f / gsum; int pos[8];
#pragma unroll
        for (int k = 0; k < 8; ++k) pos[k] = (int)__hip_atomic_fetch_add(lcnt + e[k], 1u, __ATOMIC_RELAXED, __HIP_MEMORY_SCOPE_WORKGROUP);
        typedef int i32x4 __attribute__((ext_vector_type(4)));
        i32x4* pe = (i32x4*)(wsi(C, WS_TKE) + (size_t)row * 8); i32x4* pp = (i32x4*)(wsi(C, WS_TKP) + (size_t)row * 8); f32x4* pg = (f32x4*)(wsf(C, WS_TKG) + (size_t)row * 8);
        pe[0] = (i32x4){e[0], e[1], e[2], e[3]}; pe[1] = (i32x4){e[4], e[5], e[6], e[7]};
        pp[0] = (i32x4){pos[0], pos[1], pos[2], pos[3]}; pp[1] = (i32x4){pos[4], pos[5], pos[6], pos[7]};
        pg[0] = (f32x4){g[0] * sc, g[1] * sc, g[2] * sc, g[3] * sc}; pg[1] = (f32x4){g[4] * sc, g[5] * sc, g[6] * sc, g[7] * sc};
    }
    VM_WAIT(); __syncthreads();
    if (C.tid < 256) { const unsigned n = lcnt[C.tid]; lbase[C.tid] = n ? __hip_atomic_fetch_add((unsigned*)(C.ws + WS_CTL) + CW_CNT + (l * 256 + C.tid) * 64, n, RLX_AGENT) : 0u; }
    __syncthreads();
    for (int t = gw; t < nblk; t += NGW) { const size_t o = (size_t)(t * 64 + lane) * 8;
        typedef int i32x4 __attribute__((ext_vector_type(4)));
        const i32x4* pe = (const i32x4*)(wsi(C, WS_TKE) + o); i32x4* pp = (i32x4*)(wsi(C, WS_TKP) + o);
        const i32x4 e0 = pe[0], e1 = pe[1]; i32x4 p0 = pp[0], p1 = pp[1];
        p0.x += (int)lbase[e0.x]; p0.y += (int)lbase[e0.y]; p0.z += (int)lbase[e0.z]; p0.w += (int)lbase[e0.w];
        p1.x += (int)lbase[e1.x]; p1.y += (int)lbase[e1.y]; p1.z += (int)lbase[e1.z]; p1.w += (int)lbase[e1.w];
        pp[0] = p0; pp[1] = p1; }
    __syncthreads();
}
DI int build_te(const Ctx& C, int l, LAS int* st_t, LAS int* st_s) {
    LAS unsigned short* TE = (LAS unsigned short*)(C.lds + TE_OFF + 16); LAS int* NTW = (LAS int*)(C.lds + TE_OFF); LAS int* wsum = st_s + 256;
    __syncthreads();
    int tl = 0;
    if (C.tid < 256) { const unsigned n = *((const unsigned*)(C.ws + WS_CTL) + CW_CNT + (l * 256 + C.tid) * 64); tl = (int)((n + 255u) >> 8); st_t[C.tid] = tl; }
    int v = tl;
#pragma unroll
    for (int o = 1; o < 64; o <<= 1) { const int u = __builtin_amdgcn_ds_bpermute((C.lane - o) << 2, v); if (C.lane >= o) v += u; }
    if (C.lane == 63 && C.wave < 4) wsum[C.wave] = v;
    __syncthreads();
    if (C.tid < 256) { int s = v - tl; for (int w = 0; w < C.wave; ++w) s += wsum[w]; st_s[C.tid] = s; for (int q = 0; q < tl; ++q) TE[s + q] = (unsigned short)C.tid; if (C.tid == 255) NTW[0] = s + tl; }
    __syncthreads();
    return NTW[0];
}
DI void route_slots(const Ctx& C, int l, int ntok) {
    LAS int* st_t = (LAS int*)C.lds; LAS int* st_s = st_t + 256;
    (void)build_te(C, l, st_t, st_s);
    int* stok = wsi(C, WS_STOK); float* sg = wsf(C, WS_SG) + T; int* tsl = wsi(C, WS_TSL);
    const int* tke = wsi(C, WS_TKE); const int* tkp = wsi(C, WS_TKP); const float* tkg = wsf(C, WS_TKG);
    for (int idx = C.bid * 512 + C.tid; idx < ntok * TOPK; idx += C.G * 512) { const int e = tke[idx], slot = st_s[e] * 256 + tkp[idx]; stok[slot] = idx >> 3; sg[slot] = tkg[idx]; tsl[idx] = slot; }
    for (int e = C.bid; e < NE; e += C.G) { const int n = (int)*((const unsigned*)(C.ws + WS_CTL) + CW_CNT + (l * 256 + e) * 64), hi = st_t[e] * 256;
        for (int s = n + C.tid; s < hi; s += 512) { stok[st_s[e] * 256 + s] = 0; sg[st_s[e] * 256 + s] = 0.f; } }
    __syncthreads();
}
template <int ncol, bool GATHER_> struct GroupedOrder {
    static constexpr bool GATHER = GATHER_;
    int nsh, ntile, G, c; const LAS unsigned short* TE; const int* stok;
    DI bool next(int i, pg8::Unit& u) const {
        const int total = ntile * ncol; int L;
        if ((G & 7) == 0) { const int x = c & 7, r = c >> 3, W = G >> 3, upx = (total + 7) >> 3;
            int q; if (ncol == 4) { const int upx2 = (upx + 1) & ~1; q = ((i >> 1) * W + r) * 2 + (i & 1); (void)upx2; }
            else q = i * W + r;
            if (q >= upx) return false; L = x * upx + q; }
        else L = i * G + c;
        if (L >= total) return false;
        const int ti = L / ncol, j = L - ti * ncol;
        if (ti < nsh) { u.pm = ti; u.pn = NE * ncol + j; } else { const int k = ti - nsh; u.pm = NSHT + k; u.pn = (int)TE[k] * ncol + j; }
        return true;
    }
    DI int arow(const pg8::Unit& u, int r) const { return (GATHER_ && u.pm >= NSHT) ? stok[(u.pm - NSHT) * 256 + r] : u.pm * 256 + r; }
    DI bool routed(const pg8::Unit& u) const { return GATHER_ && u.pm >= NSHT; }
    DI const int* rowlist(const pg8::Unit& u) const { return stok + (u.pm - NSHT) * 256; }
};
struct CRow { v2u y[9][2]; v4u x[2]; };
DI void crow_issue(const Ctx& C, int row, int myslot, CRow& R) {
    const unsigned char* Y = C.ws + WS_Y; const bf16* X = wsb(C, WS_X); const int lane = C.lane;
#pragma unroll
    for (int j = 0; j < 2; ++j) R.y[0][j] = *(const v2u*)(Y + (size_t)row * D + 8 * lane + 512 * j);
#pragma unroll
    for (int k = 0; k < TOPK; ++k) { const int slot = __builtin_amdgcn_readlane(myslot, k); const unsigned char* yr = Y + (size_t)(T + slot) * D + 8 * lane;
#pragma unroll
        for (int j = 0; j < 2; ++j) R.y[1 + k][j] = *(const v2u*)(yr + 512 * j); }
#pragma unroll
    for (int j = 0; j < 2; ++j) R.x[j] = *(const v4u*)(X + (size_t)row * D + 8 * lane + 512 * j);
}
DI void combine_rows(const Ctx& C, int l, int ntok) {
    const int gw = C.bid * NWAVES + C.wave, NGW = C.G * NWAVES, lane = C.lane;
    typedef float f32x2v __attribute__((ext_vector_type(2)));
    bf16* X = wsb(C, WS_X); const int* tsl = wsi(C, WS_TSL);
    const bool last = (l == DEPTH - 1);
    if (gw >= ntok) return;
    CRow Rn = {}; int s1 = 0, s2 = 0;
    { const int s0 = tsl[(size_t)gw * TOPK + (lane & 7)]; crow_issue(C, gw, s0, Rn); if (gw + NGW < ntok) s1 = tsl[(size_t)(gw + NGW) * TOPK + (lane & 7)]; }
    for (int row = gw; row < ntok; row += NGW) {
        const CRow Rc = Rn;
        if (row + NGW < ntok) crow_issue(C, row + NGW, s1, Rn);
        if (row + 2 * NGW < ntok) s2 = tsl[(size_t)(row + 2 * NGW) * TOPK + (lane & 7)];
        const int bi = row < NLAT ? (row >> 12) : 8;
        float a[2][8];
#pragma unroll
        for (int j = 0; j < 2; ++j)
#pragma unroll
            for (int i = 0; i < 8; ++i) a[j][i] = 0.f;
#pragma unroll
        for (int k = 0; k < 9; ++k)
#pragma unroll
            for (int j = 0; j < 2; ++j) { const v2u w = Rc.y[k][j];
                const f32x2v p0 = __builtin_amdgcn_cvt_pk_f32_fp8((int)w.x, false), p1 = __builtin_amdgcn_cvt_pk_f32_fp8((int)w.x, true), p2 = __builtin_amdgcn_cvt_pk_f32_fp8((int)w.y, false), p3 = __builtin_amdgcn_cvt_pk_f32_fp8((int)w.y, true);
                a[j][0] += p0.x; a[j][1] += p0.y; a[j][2] += p1.x; a[j][3] += p1.y; a[j][4] += p2.x; a[j][5] += p2.y; a[j][6] += p3.x; a[j][7] += p3.y; }
#pragma unroll
        for (int j = 0; j < 2; ++j)
#pragma unroll
            for (int i = 0; i < 8; ++i) a[j][i] *= (1.0f / 16.0f);
        const float* g2 = modp(C, l, bi, M_G2); float xn[2][8]; float ss = 0.f;
#pragma unroll
        for (int j = 0; j < 2; ++j) { const int col = 8 * lane + 512 * j; bf16* xp = X + (size_t)row * D + col;
            const v4u xw = Rc.x[j]; const f32x4 x0 = {bflo(xw.x), bfhi(xw.x), bflo(xw.y), bfhi(xw.y)}, x1 = {bflo(xw.z), bfhi(xw.z), bflo(xw.w), bfhi(xw.w)}, g0 = *(const f32x4*)(g2 + col), g1 = *(const f32x4*)(g2 + col + 4);
#pragma unroll
            for (int i = 0; i < 4; ++i) { xn[j][i] = x0[i] + g0[i] * a[j][i]; xn[j][4 + i] = x1[i] + g1[i] * a[j][4 + i]; }
#pragma unroll
            for (int i = 0; i < 8; ++i) ss += xn[j][i] * xn[j][i];
            if (!last) { v4u w; w.x = pk2(xn[j][0], xn[j][1]); w.y = pk2(xn[j][2], xn[j][3]); w.z = pk2(xn[j][4], xn[j][5]); w.w = pk2(xn[j][6], xn[j][7]); *(v4u*)xp = w; } }
        const float rstd = rsqrtf(wave_sum(ss, C.lane) * (1.0f / D) + RMS_EPS);
        if (!last) {
            const float* gn = inp(C, I_N1G) + (l + 1) * D; const float* sh = modp(C, l + 1, bi, M_SH1); const float* sc = modp(C, l + 1, bi, M_SC1); unsigned char* H8 = C.ws + WS_H8;
#pragma unroll
            for (int j = 0; j < 2; ++j) { const int col = 8 * lane + 512 * j; float y[8];
#pragma unroll
                for (int i = 0; i < 8; ++i) y[i] = xn[j][i] * rstd * gn[col + i] * (1.0f + sc[col + i]) + sh[col + i];
                v2u w; w.x = pk4_fp8(y[0], y[1], y[2], y[3]); w.y = pk4_fp8(y[4], y[5], y[6], y[7]); *(v2u*)(H8 + (size_t)row * D + col) = w; }
        } else {
            const float* gn = inp(C, I_FG);
#pragma unroll
            for (int j = 0; j < 2; ++j) { const int col = 8 * lane + 512 * j; float* op = C.out + (size_t)row * D + col;
                *(f32x4*)op = (f32x4){xn[j][0] * rstd * gn[col], xn[j][1] * rstd * gn[col + 1], xn[j][2] * rstd * gn[col + 2], xn[j][3] * rstd * gn[col + 3]};
                *(f32x4*)(op + 4) = (f32x4){xn[j][4] * rstd * gn[col + 4], xn[j][5] * rstd * gn[col + 5], xn[j][6] * rstd * gn[col + 6], xn[j][7] * rstd * gn[col + 7]}; }
        }
        s1 = s2;
    }
}

constexpr int SPL = 13;
constexpr int N_STEPS = 2 + SPL * DEPTH;
__global__ void __launch_bounds__(NWAVES * 64, 2) fwd_kernel(Args args) {
    extern __shared__ __attribute__((aligned(16))) unsigned char lds_raw[];
    Ctx C;
#pragma unroll
    for (int i = 0; i < 25; ++i) C.in[i] = args.in[i];
    unsigned char* const ws0 = args.ws; float* const out0 = args.out;
    C.z = 0; C.out = out0; C.ws = ws0; C.lds = (LAS unsigned char*)lds_raw;
    const int wv0 = __builtin_amdgcn_readfirstlane((int)threadIdx.x >> 6);
#define TIDX() ({ int l_; asm volatile("v_mbcnt_lo_u32_b32 %0, -1, 0\n\tv_mbcnt_hi_u32_b32 %0, -1, %0" : "=v"(l_)); wv0 * 64 + l_; })
    C.tid = TIDX(); C.lane = C.tid & 63; C.wave = wv0; C.bid = blockIdx.x; C.G = gridDim.x;
    for (int u = C.tid; u < (LDS_BYTES - LDSCTL_OFF) / 4; u += NWAVES * 64) ((LAS unsigned*)(C.lds + LDSCTL_OFF))[u] = 0u;
    __syncthreads();
    volatile LAS unsigned* MISC = (volatile LAS unsigned*)(C.lds + MISC_OFF);
    XcdBarrier bar = xcd_barrier_post((unsigned*)(C.ws + WS_CTL) + CW_BAR, MISC + 8, TIDX() == 0);
    const int lo = args.ph_lo, hi = args.ph_hi;
    float sc8;
#ifndef PHMASK
#define PHMASK 0xFFFFFFFFu
#endif
#ifndef REPMASK
#define REPMASK 0u
#endif
#define NREP(k) ((((REPMASK) >> (k)) & 1u) ? 2 : 1)
#define PHK(k) (((PHMASK) >> (k)) & 1u)
#define IN(k) (PHK((k) < 2 ? (k) : 2 + (((k) - 2) % SPL)) && lo <= (k) && (k) < hi)
#define SEAM(k) do { if (IN(k) && IN((k) + 1)) xcd_barrier(bar, TIDX() == 0); } while (0)
#define PH_BEGIN() do { sc8 = 1.0f / W8_SCALE; asm volatile("" : "+s"(sc8)); int t_ = TIDX(); asm volatile("" : "+v"(t_)); C.tid = t_; C.lane = t_ & 63; C.wave = __builtin_amdgcn_readfirstlane(t_ >> 6); asm volatile("" : "+s"(C.bid), "+s"(C.G)); { size_t z_ = 0; asm volatile("" : "+s"(z_)); C.z = z_; C.ws = ws0 + z_; C.out = out0 + z_; } } while (0)

    if (IN(0)) for (int rep_ = 0; rep_ < NREP(0); ++rep_) { PH_BEGIN();
        if (C.bid < 192) p0_mod(C);
        if (C.bid == C.G - 1) p0_tables(C);
        p0_transposes(C);
    }
    SEAM(0);
    if (IN(1)) for (int rep_ = 0; rep_ < NREP(1); ++rep_) { PH_BEGIN(); norm_mod_rows<true>(C, inp(C, I_X), inp(C, I_CTX), inp(C, I_N1G), 0, M_SH1, M_SC1, nullptr, C.ws + WS_H8, T); }
    SEAM(1);

    for (int l = 0; l < DEPTH; ++l) {
        const int s0 = 2 + SPL * l; const bool last = (l == DEPTH - 1);
        const int nrow = last ? NLAT : T;
        if (IN(s0 + 0)) for (int rep_ = 0; rep_ < NREP(2); ++rep_) { PH_BEGIN();
            pg8::Gemm g{(const bf16*)(C.ws + WS_H8), wl(C, l, W_IN), D / 2, D / 2}; pg8::StaticOrder S; S.init(T, INC, C.G, C.bid);
            pg8::EpiBf16 E{wsb(C, WS_Z), INC, sc8, C.ws + WS_G8, C_BG / 256};
            pg8::gemm_phase<pg8::EpiBf16, pg8::StaticOrder, true, true>(C.lds, g, S, E, C.tid);
        }
        SEAM(s0 + 0);
        if (IN(s0 + 1)) for (int rep_ = 0; rep_ < NREP(3); ++rep_) { PH_BEGIN();
            load_cs_table(C);
            ((LAS float*)(C.lds + L_S0 + 28672))[C.tid] = hg_lb(C, l, C.tid >> 8, C.tid & 255);
            __syncthreads();
            static_assert(64 * NCHUNK == 4096 + 256, "the V^T copy units pair one to one with the HGRN chunk-state units");
            { v4u pr[2] = {}, pv[1] = {}, pf[1] = {}; int u = C.bid; if (u < 64 * NCHUNK) { hgrn1_load(C, u, pr); vt_load(C, u, pv); } if (u < 2048) fft1_load(C, u, pf);
              for (int it_ = 0; u < 64 * NCHUNK; u += C.G, ++it_) { const v4u cr[2] = {pr[0], pr[1]}; const v4u cv[1] = {pv[0]}; const v4u cf[1] = {pf[0]};
                  if (u + C.G < 64 * NCHUNK) { hgrn1_load(C, u + C.G, pr); vt_load(C, u + C.G, pv); } if (u + C.G < 2048) fft1_load(C, u + C.G, pf);
                  vt_stage(C, cv); hgrn1_unit(C, l, u, cr, u < 2048, u, cf, it_ & 1); } }
            __syncthreads();
        }
        SEAM(s0 + 1);
        if (IN(s0 + 2)) for (int rep_ = 0; rep_ < NREP(4); ++rep_) { PH_BEGIN();
            load_cs_table(C);
            { LAS float* rpb = (LAS float*)(C.lds + L_RPB); const float* src = inp(C, I_RPB) + (size_t)l * 8 * 465; float t[8];
#pragma unroll
              for (int j = 0; j < 8; ++j) { const int i = C.tid + 512 * j; t[j] = i < 8 * 465 ? src[i] : 0.f; }
#pragma unroll
              for (int j = 0; j < 8; ++j) { const int i = C.tid + 512 * j; if (i < 8 * 465) rpb[i] = t[j]; } }
            __syncthreads();
            for (int it = C.bid; it < 512; it += C.G) hgrn2_item(C, it);
            { v4u pr[2] = {}; int u = C.bid; if (u < 2048) fft2_load(C, u, pr); for (; u < 2048; u += C.G) { const v4u cr[2] = {pr[0], pr[1]}; if (u + C.G < 2048) fft2_load(C, u + C.G, pr); fft2_unit(C, u, cr); } }
            attn_phase(C, l, !last);
            __syncthreads();
        }
        SEAM(s0 + 2);
        if (IN(s0 + 3)) for (int rep_ = 0; rep_ < NREP(5); ++rep_) { PH_BEGIN();
            if (!last) {
                load_cs_table(C); __syncthreads();
                const int c0 = C.G >= 256 ? C.bid - 128 : C.bid; if (c0 >= 0) for (int u = c0; u < 128; u += C.G) cfft_unit(C, u);
                __syncthreads(); }
            ((LAS float*)(C.lds + L_S0 + 106496))[C.tid] = hg_lb(C, l, C.tid >> 8, C.tid & 255); __syncthreads();
            { const int NU = last ? 32 * 64 : 32 * NCHUNK;
              v4u pr[4] = {}; int u = C.bid; if (u < NU) hgrn3_load(C, last ? (u >> 6) * NCHUNK + (u & 63) : u, pr);
              for (; u < NU; u += C.G) { const v4u cr[4] = {pr[0], pr[1], pr[2], pr[3]}; const int un = u + C.G; if (un < NU) hgrn3_load(C, last ? (un >> 6) * NCHUNK + (un & 63) : un, pr);
                  hgrn3_unit(C, l, last ? (u >> 6) * NCHUNK + (u & 63) : u, cr); } }
            __syncthreads();
        }
        SEAM(s0 + 3);
        if (IN(s0 + 4)) for (int rep_ = 0; rep_ < NREP(6); ++rep_) { PH_BEGIN();
            pg8::StaticOrder S; S.init(nrow, D, C.G, C.bid); bf16* const Z = wsb(C, WS_Z); bf16* const MIX = wsb(C, WS_MIX); bf16* const MG = wsb(C, WS_MG);
            const bf16* const MIX8 = (const bf16*)(C.ws + WS_MIX); (void)MIX;
            { pg8::Gemm g{MIX8, wl(C, l, W_FN), D / 2, D / 2}; pg8::EpiBranchCat E{MG, C.ws + WS_G8, D, 3072, sc8}; pg8::gemm_phase<pg8::EpiBranchCat, pg8::StaticOrder, true, true>(C.lds, g, S, E, C.tid); }
        }
        SEAM(s0 + 4);
        if (IN(s0 + 5)) for (int rep_ = 0; rep_ < NREP(7); ++rep_) { PH_BEGIN();
            bf16* const X = wsb(C, WS_X); pg8::Gemm g{wsb(C, WS_MG), wl(C, l, W_OUT), D / 2, D / 2}; pg8::StaticOrder S; S.init(nrow, D, C.G, C.bid);
            if (l == 0) { pg8::EpiResid<true> E{X, inp(C, I_X), inp(C, I_CTX), modp(C, l, 0, M_G1), NLAT, 6144, sc8}; pg8::gemm_phase<pg8::EpiResid<true>, pg8::StaticOrder, true, true>(C.lds, g, S, E, C.tid); }
            else { pg8::EpiResid<false> E{X, nullptr, nullptr, modp(C, l, 0, M_G1), NLAT, 6144, sc8}; pg8::gemm_phase<pg8::EpiResid<false>, pg8::StaticOrder, true, true>(C.lds, g, S, E, C.tid); }
        }
        SEAM(s0 + 5);
        if (IN(s0 + 6)) for (int rep_ = 0; rep_ < NREP(8); ++rep_) { PH_BEGIN(); norm_mod_rows<false>(C, wsb(C, WS_X), nullptr, inp(C, I_N2G) + l * D, l, M_SH2, M_SC2, wsb(C, WS_H), C.ws + WS_H8, nrow); }
        SEAM(s0 + 6);
        if (IN(s0 + 7)) for (int rep_ = 0; rep_ < NREP(9); ++rep_) { PH_BEGIN();
            pg8::Gemm g{wsb(C, WS_H), wl(C, l, W_R), D, D}; pg8::StaticOrder S; S.init(nrow, 256, C.G, C.bid);
            pg8::EpiF32 E{wsf(C, WS_SC), 256};
            pg8::gemm_phase<pg8::EpiF32, pg8::StaticOrder>(C.lds, g, S, E, C.tid);
        }
        SEAM(s0 + 7);
        if (IN(s0 + 8)) { PH_BEGIN(); topk_phase(C, l, nrow); }
        SEAM(s0 + 8);
        if (IN(s0 + 9)) for (int rep_ = 0; rep_ < NREP(11); ++rep_) { PH_BEGIN(); route_slots(C, l, nrow); }
        SEAM(s0 + 9);
        if (IN(s0 + 10)) for (int rep_ = 0; rep_ < NREP(12); ++rep_) { PH_BEGIN();
            LAS int* st_t = (LAS int*)C.lds; const int NT = build_te(C, l, st_t, st_t + 256);
            __syncthreads();
            GroupedOrder<2, true> S{nrow / 256, nrow / 256 + NT, C.G, C.bid, (const LAS unsigned short*)(C.lds + TE_OFF + 16), wsi(C, WS_STOK)};
            pg8::Gemm g{(const bf16*)(C.ws + WS_H8), wl(C, l, W_GU), D / 2, D / 2}; pg8::EpiGateUp E{wsb(C, WS_HS), wsf(C, WS_SG), T, sc8};
            pg8::gemm_phase<pg8::EpiGateUp, GroupedOrder<2, true>, true, true>(C.lds, g, S, E, C.tid);
        }
        SEAM(s0 + 10);
        if (IN(s0 + 11)) for (int rep_ = 0; rep_ < NREP(13); ++rep_) { PH_BEGIN();
            LAS int* st_t = (LAS int*)C.lds; const int NT = build_te(C, l, st_t, st_t + 256);
            __syncthreads();
            GroupedOrder<4, false> S{nrow / 256, nrow / 256 + NT, C.G, C.bid, (const LAS unsigned short*)(C.lds + TE_OFF + 16), nullptr};
            pg8::Gemm g{wsb(C, WS_HS), wl(C, l, W_D), 128, 128}; pg8::EpiDown E{C.ws + WS_Y};
            pg8::gemm_phase<pg8::EpiDown, GroupedOrder<4, false>, true, true>(C.lds, g, S, E, C.tid);
        }
        SEAM(s0 + 11);
        if (IN(s0 + 12)) for (int rep_ = 0; rep_ < NREP(14); ++rep_) { PH_BEGIN(); combine_rows(C, l, nrow); }
        if (!last) SEAM(s0 + 12);
    }
#undef IN
#undef SEAM
}

#ifndef MK_PER_STEP
#define MK_PER_STEP 0
#endif
extern "C" void kernel_launch(void* const* d_in, const int* in_sizes, int n_in, void* d_out, int out_size, void* d_ws, size_t ws_size, hipStream_t stream) {
    static int grid = 0;
    if (grid == 0) {
        if (n_in != 25 || in_sizes[0] != NLAT * D || out_size != NLAT * D || ws_size < WS_END) { fprintf(stderr, "kernel_launch: unexpected shapes (n_in %d, in0 %d, out %d, ws %zu < %zu); nothing launched\n", n_in, n_in > 0 ? in_sizes[0] : -1, out_size, ws_size, (size_t)WS_END); grid = -1; return; }
        int dev = 0, cus = 0, per_cu = 0;
        if (hipGetDevice(&dev) != hipSuccess || hipDeviceGetAttribute(&cus, hipDeviceAttributeMultiprocessorCount, dev) != hipSuccess) { grid = -1; return; }
        if (hipFuncSetAttribute((const void*)fwd_kernel, hipFuncAttributeMaxDynamicSharedMemorySize, LDS_BYTES) != hipSuccess) { fprintf(stderr, "kernel_launch: hipFuncSetAttribute failed\n"); grid = -1; return; }
        if (hipOccupancyMaxActiveBlocksPerMultiprocessor(&per_cu, (const void*)fwd_kernel, NWAVES * 64, LDS_BYTES) != hipSuccess || per_cu < 1) fprintf(stderr, "kernel_launch: note: occupancy query says %d\n", per_cu);
        (void)hipGetLastError();
        grid = cus;
    }
    if (grid < 0) return;
    if (hipMemsetAsync((char*)d_ws + WS_CTL, 0, CTL_ZERO_BYTES, stream) != hipSuccess) return;
    Args a{};
    for (int i = 0; i < 25; ++i) a.in[i] = (const float*)d_in[i];
    a.out = (float*)d_out; a.ws = (unsigned char*)d_ws;
#if MK_PER_STEP
    for (int s = 0; s < N_STEPS; ++s) { a.ph_lo = s; a.ph_hi = s + 1; hipLaunchKernelGGL(fwd_kernel, dim3(grid), dim3(NWAVES * 64), LDS_BYTES, stream, a); }
#else
    a.ph_lo = 0; a.ph_hi = N_STEPS;
    hipLaunchKernelGGL(fwd_kernel, dim3(grid), dim3(NWAVES * 64), LDS_BYTES, stream, a);
#endif
}
```
